# Optimizing an MI355X kernel written in HIP

```python
import jax, jax.numpy as jnp
from jax import lax
import numpy as np

D_MODEL = 1024
BATCH = 8
SEQ = 2048
DEPTH = 2
DEC_BATCH = 128
DEC_SEQ = 1
PAST_LEN = 16384
PAGE_SIZE = 128

N_EVEN = (DEPTH + 1) // 2
N_ODD = DEPTH // 2
D_POOL = D_MODEL // 2
POOL_WINDOWS = (2, 4, 8, 16)
N_POOL_GROUPS = len(POOL_WINDOWS)
POOL_GROUP = D_POOL // N_POOL_GROUPS
POOL_HIST = max(POOL_WINDOWS) - 1
D_CONV = D_MODEL // 2
CONV_WIDTH = 3
CONV_HIST = CONV_WIDTH - 1
D_IN_EVEN = D_POOL + 3 * D_CONV
D_MIX_EVEN = D_POOL + D_CONV
D_GATE = D_MODEL
CHUNK = 128
N_SG_HEADS = 8
SG_HEAD = D_GATE // N_SG_HEADS
D_FF = -(-8 * D_MODEL // (3 * 256)) * 256
EPS = 1e-6

kernel_name = "hybrid_pool_shortconv_chunkgmlp_decode_step"


def rmsnorm(x, g):
    xf = x.astype(jnp.float32)
    y = xf * lax.rsqrt(jnp.mean(xf * xf, axis=-1, keepdims=True) + EPS)
    return (y * g.astype(jnp.float32)).astype(x.dtype)


def swiglu(h, w_gate, w_up, w_down):
    return (jax.nn.silu(h @ w_gate) * (h @ w_up)) @ w_down


def pool_mixer(hist, p, start, w_pool, scale):
    B, T, _ = p.shape
    full = jnp.concatenate([hist, p], axis=1)
    cs = jnp.cumsum(full.astype(jnp.float32), axis=1)
    cs = jnp.pad(cs, ((0, 0), (1, 0), (0, 0)))
    pos = start + jnp.arange(T)
    outs = []
    for g, w in enumerate(POOL_WINDOWS):
        sl = slice(g * POOL_GROUP, (g + 1) * POOL_GROUP)
        hi = cs[:, POOL_HIST + 1:POOL_HIST + 1 + T, sl]
        lo = cs[:, POOL_HIST + 1 - w:POOL_HIST + 1 - w + T, sl]
        cnt = jnp.minimum(pos + 1, w).astype(jnp.float32)[None, :, None]
        outs.append((hi - lo) / cnt)
    pooled = jnp.stack(outs, axis=2)
    pg = p.reshape(B, T, N_POOL_GROUPS, POOL_GROUP).astype(jnp.float32)
    d = (pooled - pg).astype(p.dtype)
    mixed = jnp.einsum('btgc,gcd->btgd', d, w_pool).reshape(B, T, D_POOL)
    return mixed * scale, full[:, -POOL_HIST:]


def conv_mixer(hist, xb, b_gate, c_gate, conv_w):
    T = xb.shape[1]
    full = jnp.concatenate([hist, c_gate * xb], axis=1)
    y = full[:, 0:T] * conv_w[0]
    for k in range(1, CONV_WIDTH):
        y = y + full[:, k:k + T] * conv_w[k]
    return b_gate * y, full[:, -CONV_HIST:]


def chunk_gating(z, g_v, w_s, b_s):
    B, T, _ = z.shape
    u, v = z[..., :D_GATE], z[..., D_GATE:]
    v = rmsnorm(v, g_v)
    Tp = -(-T // CHUNK) * CHUNK
    vp = jnp.pad(v, ((0, 0), (0, Tp - T), (0, 0))).reshape(B, Tp // CHUNK, CHUNK, N_SG_HEADS, SG_HEAD)
    mask = jnp.tril(jnp.ones((CHUNK, CHUNK), dtype=bool))
    ws = jnp.where(mask[None], w_s, jnp.zeros((), w_s.dtype))
    mixed = jnp.einsum('hts,bnshd->bnthd', ws, vp) + b_s.T[None, None, :, :, None]
    mixed = mixed.reshape(B, Tp, D_GATE)[:, :T]
    return u * mixed, v


def run_group(x, start, pool_hist, conv_hist, norm_mix, norm_ffn, norm_final,
              w_in_even, w_pool, pool_scale, conv_w, w_out_even,
              w_in_odd, norm_sg, w_s, b_s, w_out_odd,
              ffn_w_gate, ffn_w_up, ffn_w_down):
    pool_new, conv_new, v_new = [], [], []
    for layer in range(DEPTH):
        h = rmsnorm(x, norm_mix[layer])
        if layer % 2 == 0:
            e = layer // 2
            z = h @ w_in_even[e]
            p, xb, bg, cg = jnp.split(z, [D_POOL, D_POOL + D_CONV, D_POOL + 2 * D_CONV], axis=-1)
            a_out, ph = pool_mixer(pool_hist[e], p, start, w_pool[e], pool_scale[e])
            b_out, ch = conv_mixer(conv_hist[e], xb, bg, cg, conv_w[e])
            mix = jnp.concatenate([a_out, b_out], axis=-1) @ w_out_even[e]
            pool_new.append(ph)
            conv_new.append(ch)
        else:
            o = layer // 2
            z = jax.nn.gelu(h @ w_in_odd[o], approximate=False)
            c_out, v = chunk_gating(z, norm_sg[o], w_s[o], b_s[o])
            mix = c_out @ w_out_odd[o]
            v_new.append(v)
        x = x + mix
        h = rmsnorm(x, norm_ffn[layer])
        x = x + swiglu(h, ffn_w_gate[layer], ffn_w_up[layer], ffn_w_down[layer])
    return rmsnorm(x, norm_final), jnp.stack(pool_new), jnp.stack(conv_new), jnp.stack(v_new)


def setup_inputs(seed: int = 0) -> dict:
    key = jax.random.key(seed)
    ks = jax.random.split(key, 24)
    nrm = lambda k, shape, s: jax.random.normal(k, shape, jnp.float32) * s
    return {
        "x_prompt": nrm(ks[0], (BATCH, SEQ, D_MODEL), 1.0),
        "x_sample": nrm(ks[1], (DEC_BATCH, DEC_SEQ, D_MODEL), 1.0),
        "state_pool": nrm(ks[2], (N_EVEN, DEC_BATCH, POOL_HIST, D_POOL), 1.0),
        "state_conv": nrm(ks[3], (N_EVEN, DEC_BATCH, CONV_HIST, D_CONV), 1.0),
        "norm_mix": 1.0 + nrm(ks[4], (DEPTH, D_MODEL), 0.05),
        "norm_ffn": 1.0 + nrm(ks[5], (DEPTH, D_MODEL), 0.05),
        "norm_final": 1.0 + nrm(ks[6], (D_MODEL,), 0.05),
        "w_in_even": nrm(ks[7], (N_EVEN, D_MODEL, D_IN_EVEN), D_MODEL ** -0.5),
        "w_pool": nrm(ks[8], (N_EVEN, N_POOL_GROUPS, POOL_GROUP, POOL_GROUP), POOL_GROUP ** -0.5),
        "pool_scale": 1.0 + nrm(ks[9], (N_EVEN, D_POOL), 0.1),
        "conv_w": nrm(ks[10], (N_EVEN, CONV_WIDTH, D_CONV), CONV_WIDTH ** -0.5),
        "w_out_even": nrm(ks[11], (N_EVEN, D_MIX_EVEN, D_MODEL), D_MIX_EVEN ** -0.5),
        "w_in_odd": nrm(ks[12], (N_ODD, D_MODEL, 2 * D_GATE), D_MODEL ** -0.5),
        "norm_sg": 1.0 + nrm(ks[13], (N_ODD, D_GATE), 0.05),
        "w_s": nrm(ks[14], (N_ODD, N_SG_HEADS, CHUNK, CHUNK), CHUNK ** -0.5),
        "b_s": 1.0 + nrm(ks[15], (N_ODD, N_SG_HEADS, CHUNK), 0.1),
        "w_out_odd": nrm(ks[16], (N_ODD, D_GATE, D_MODEL), D_GATE ** -0.5),
        "ffn_w_gate": nrm(ks[17], (DEPTH, D_MODEL, D_FF), D_MODEL ** -0.5),
        "ffn_w_up": nrm(ks[18], (DEPTH, D_MODEL, D_FF), D_MODEL ** -0.5),
        "ffn_w_down": nrm(ks[19], (DEPTH, D_FF, D_MODEL), D_FF ** -0.5),
    }


def reference(x_prompt, x_sample, state_pool, state_conv, norm_mix, norm_ffn, norm_final,
              w_in_even, w_pool, pool_scale, conv_w, w_out_even,
              w_in_odd, norm_sg, w_s, b_s, w_out_odd,
              ffn_w_gate, ffn_w_up, ffn_w_down):
    weights = (norm_mix, norm_ffn, norm_final, w_in_even, w_pool, pool_scale, conv_w, w_out_even,
               w_in_odd, norm_sg, w_s, b_s, w_out_odd, ffn_w_gate, ffn_w_up, ffn_w_down)
    pool0 = jnp.zeros((N_EVEN, BATCH, POOL_HIST, D_POOL), x_prompt.dtype)
    conv0 = jnp.zeros((N_EVEN, BATCH, CONV_HIST, D_CONV), x_prompt.dtype)
    y_prompt, pool_p, conv_p, _v_p = run_group(x_prompt, 0, pool0, conv0, *weights)
    y_sample, pool_s, conv_s, v_s = run_group(x_sample, PAST_LEN, state_pool, state_conv, *weights)
    return (y_prompt, y_sample, pool_p, pool_s, conv_p, conv_s, v_s)
```

```cpp
#include <hip/hip_runtime.h>
#include <cstdio>

#ifndef N_LAUNCHES
#define N_LAUNCHES 1
#endif

#define LAS __attribute__((address_space(3)))
typedef unsigned short bf16_t;
typedef short bf16x8 __attribute__((ext_vector_type(8)));
typedef float f32x4 __attribute__((ext_vector_type(4)));
typedef float f32x2 __attribute__((ext_vector_type(2)));
typedef unsigned u32x4 __attribute__((ext_vector_type(4)));
typedef unsigned u32x2 __attribute__((ext_vector_type(2)));

constexpr int D = 1024, T = 2048, MP = 16384, MS = 128, MTOT = MP + MS, MPAD = MP + 256, DFF = 2816;
constexpr float EPS = 1e-6f;
constexpr int NPHASE = 12;
constexpr int LDS_STAGE = 131072;
constexpr int RTAB_OFF = LDS_STAGE + 16;
constexpr int SRED_OFF = RTAB_OFF + 8 * 256 * 4;
constexpr int LDS_BYTES = SRED_OFF + 256;

constexpr size_t OFF_W_INE = 0;
constexpr size_t OFF_W_OUTE = OFF_W_INE + 4194304;
constexpr size_t OFF_W_GU0 = OFF_W_OUTE + 2097152;
constexpr size_t OFF_W_DN0 = OFF_W_GU0 + 11534336;
constexpr size_t OFF_W_INO = OFF_W_DN0 + 5767168;
constexpr size_t OFF_W_OUTO = OFF_W_INO + 4194304;
constexpr size_t OFF_W_GU1 = OFF_W_OUTO + 2097152;
constexpr size_t OFF_W_DN1 = OFF_W_GU1 + 11534336;
constexpr size_t OFF_W_POOL = OFF_W_DN1 + 5767168;
constexpr size_t OFF_W_WS = OFF_W_POOL + 131072;
constexpr size_t OFF_XB = OFF_W_WS + 262144;
constexpr size_t OFF_ZB = OFF_XB + (size_t)MPAD * 1024 * 2;
constexpr size_t OFF_MIXB = OFF_ZB + (size_t)MTOT * 2048 * 2;
constexpr size_t OFF_ST = OFF_MIXB + (size_t)MTOT * 1024 * 2;
constexpr size_t ST_BYTES = (size_t)MPAD * 16 * 4;
constexpr size_t OFF_BAR = OFF_ST + 6 * ST_BYTES;
constexpr size_t BAR_BYTES = 65536;
constexpr size_t WS_END = OFF_BAR + BAR_BYTES;
constexpr size_t OFF_HB = OFF_ZB;
static_assert((size_t)MPAD * DFF * 2 <= (size_t)MTOT * 3072 * 2, "HB alias");

constexpr size_t OUT_Y = 0;
constexpr size_t OUT_POOLP = (size_t)MTOT * 1024;
constexpr size_t OUT_POOLS = OUT_POOLP + 8 * 15 * 512;
constexpr size_t OUT_CONVP = OUT_POOLS + 128 * 15 * 512;
constexpr size_t OUT_CONVS = OUT_CONVP + 8 * 2 * 512;
constexpr size_t OUT_SGV = OUT_CONVS + 128 * 2 * 512;

struct Params { const float* in[20]; float* out; unsigned char* ws; int ph_lo, ph_hi; };

#define LDS_BARRIER() do { asm volatile("s_waitcnt lgkmcnt(0)" ::: "memory"); __builtin_amdgcn_s_barrier(); asm volatile("" ::: "memory"); } while (0)
__device__ __forceinline__ unsigned cvt_pk_bf16(float lo, float hi) { unsigned r; asm("v_cvt_pk_bf16_f32 %0, %1, %2" : "=v"(r) : "v"(lo), "v"(hi)); return r; }
__device__ __forceinline__ bf16_t f2bf(float f) { unsigned u = __float_as_uint(f); u += 0x7FFFu + ((u >> 16) & 1u); return (bf16_t)(u >> 16); }
__device__ __forceinline__ float bf2f(bf16_t b) { return __uint_as_float(((unsigned)b) << 16); }
__device__ __forceinline__ float bflo(unsigned u) { return __uint_as_float(u << 16); }
__device__ __forceinline__ float bfhi(unsigned u) { return __uint_as_float(u & 0xffff0000u); }
__device__ __forceinline__ float hsum4(f32x4 v) { return (v[0] + v[1]) + (v[2] + v[3]); }
__device__ __forceinline__ float dot4(f32x4 v) { return (v[0] * v[0] + v[1] * v[1]) + (v[2] * v[2] + v[3] * v[3]); }
__device__ __forceinline__ u32x2 pack4(f32x4 v) { u32x2 w; w.x = cvt_pk_bf16(v[0], v[1]); w.y = cvt_pk_bf16(v[2], v[3]); return w; }
__device__ __forceinline__ f32x4 ldnt(const f32x4* p) { return __builtin_nontemporal_load(p); }
__device__ __forceinline__ u32x4 ldnt(const u32x4* p) { return __builtin_nontemporal_load(p); }
__device__ __forceinline__ float wave_sum(float s) { s += __shfl_xor(s, 1); s += __shfl_xor(s, 2); s += __shfl_xor(s, 4); s += __shfl_xor(s, 8); s += __shfl_xor(s, 16); s += __shfl_xor(s, 32); return s; }
__device__ __forceinline__ float quad_sum(float s) { s += __shfl_xor(s, 16); s += __shfl_xor(s, 32); return s; }

__device__ __forceinline__ f32x2 gelu_pk(f32x2 v) {
    const f32x2 av = __builtin_elementwise_abs(v), d = av * 0.2316418882f + 1.0f;
    f32x2 t; t.x = __builtin_amdgcn_rcpf(d.x); t.y = __builtin_amdgcn_rcpf(d.y);
    f32x2 q = t * 0.5307027145f + (-0.7265760135f); q = q * t + 0.7107068705f; q = q * t + (-0.142248368f); q = q * t + 0.127414796f; q = q * t;
    const f32x2 s = (v * v) * (-0.72134752044f);
    f32x2 e; e.x = __builtin_amdgcn_exp2f(s.x); e.y = __builtin_amdgcn_exp2f(s.y);
    const f32x2 m = v * (q * e), r = v - m;
    f32x2 o; o.x = v.x < 0.f ? m.x : r.x; o.y = v.y < 0.f ? m.y : r.y; return o;
}
__device__ __forceinline__ f32x4 gelu4(f32x4 v) { f32x2 a = gelu_pk((f32x2){v[0], v[1]}), b = gelu_pk((f32x2){v[2], v[3]}); return (f32x4){a.x, a.y, b.x, b.y}; }
__device__ __forceinline__ float silu1(float g) { return g * __builtin_amdgcn_rcpf(1.0f + __expf(-g)); }
__device__ __forceinline__ f32x4 swiglu4(f32x4 g, f32x4 u) { return (f32x4){silu1(g[0]) * u[0], silu1(g[1]) * u[1], silu1(g[2]) * u[2], silu1(g[3]) * u[3]}; }

constexpr int BM = 256, BK = 64, HALF = 128, HTB = HALF * BK * 2, NXCD = 8, WGM = 4;
__device__ __forceinline__ int lds_byte(int r, int c) { const int st = (r >> 4) * 2 + (c >> 5), rr = r & 15, cc = c & 31, ob = rr * 64 + cc * 2; return st * 1024 + (ob ^ (((ob >> 9) & 1) << 5)); }
__device__ __forceinline__ void stage_rc(int b, int& R, int& C) { const int st = b / 1024, sb = b % 1024, swz = sb ^ (((sb >> 9) & 1) << 5); R = (st >> 1) * 16 + swz / 64; C = (st & 1) * 32 + (swz % 64) / 2; }

__device__ __forceinline__ int perm32(int rho) { const int n = rho >> 4, i = rho & 15; return 8 * (i >> 2) + 4 * n + (i & 3); }
struct Unit { int pm, pn; };
struct SOrder {
    int nM, nN, nwg, G, c;
    __device__ __forceinline__ void init(int nM_, int N, int G_, int c_) { nM = nM_; nN = N / BM; nwg = nM * nN; G = G_; c = c_; }
    __device__ __forceinline__ bool next(int i, Unit& u) const {
        const long L = (long)i * G + c; if (L >= nwg) return false;
        int wgid = (int)L; { const int q = nwg / NXCD, r = nwg % NXCD, xcd = wgid % NXCD, off = wgid / NXCD; wgid = (xcd < r ? xcd * (q + 1) : r * (q + 1) + (xcd - r) * q) + off; }
        const int nig = WGM * nN, gid = wgid / nig, fm = gid * WGM, gsz = (nM - fm) < WGM ? (nM - fm) : WGM;
        u.pm = fm + ((wgid % nig) % gsz); u.pn = (wgid % nig) / gsz; return true;
    }
};

enum { EK_SCALE = 0, EK_RES = 1, EK_SWIGLU = 2, EK_GELU = 3, EK_FINAL = 4 };
struct EpiArgs {
    bf16_t* ob; int ldb;
    const bf16_t* res;
    const float* stIn;
    float* stOut;
    float* yout;
    const float* gfin;
    unsigned* cnt;
    unsigned* scnt;
};

template <int EK>
__device__ __forceinline__ void epi_tile(const f32x4 (&acc)[2][2][4][2], const Unit& u, int wr, int wc, int fr, int fq, const EpiArgs& E, const LAS float* rt) {
    const int rowb = u.pm * BM + wr * 64 + fr;
    float rr[2][4];
    if (EK != EK_RES) {
#pragma unroll
        for (int ai = 0; ai < 2; ++ai)
#pragma unroll
            for (int m = 0; m < 4; ++m) rr[ai][m] = rt[ai * HALF + wr * 64 + m * 16 + fr];
    }
#pragma unroll
    for (int ai = 0; ai < 2; ++ai) {
#pragma unroll
        for (int m = 0; m < 4; ++m) {
            const int row = rowb + ai * HALF + m * 16;
            if (EK == EK_SCALE) {
                const float r = rr[ai][m];
#pragma unroll
                for (int bj = 0; bj < 2; ++bj) { const int col = u.pn * BM + bj * HALF + wc * 32 + fq * 8;
                    const u32x2 lo = pack4(acc[ai][bj][m][0] * r), hi = pack4(acc[ai][bj][m][1] * r);
                    *(u32x4*)(E.ob + (size_t)row * E.ldb + col) = (u32x4){lo.x, lo.y, hi.x, hi.y}; }
            } else if (EK == EK_GELU) {
                const float r = rr[ai][m]; float ss = 0.f;
#pragma unroll
                for (int bj = 0; bj < 2; ++bj) { const int col = u.pn * BM + bj * HALF + wc * 32 + fq * 8;
                    const f32x4 z0 = gelu4(acc[ai][bj][m][0] * r), z1 = gelu4(acc[ai][bj][m][1] * r); ss += dot4(z0) + dot4(z1);
                    const u32x2 lo = pack4(z0), hi = pack4(z1);
                    *(u32x4*)(E.ob + (size_t)row * E.ldb + col) = (u32x4){lo.x, lo.y, hi.x, hi.y}; }
                if (u.pn >= 4) { ss = quad_sum(ss); if (fq == 0) E.stOut[(size_t)row * 16 + (u.pn - 4) * 4 + wc] = ss; }
            } else if (EK == EK_SWIGLU) {
                const float r = rr[ai][m];
                { const int col = u.pn * HALF + wc * 32 + fq * 8;
                    const u32x2 lo = pack4(swiglu4(acc[ai][0][m][0] * r, acc[ai][1][m][0] * r)), hi = pack4(swiglu4(acc[ai][0][m][1] * r, acc[ai][1][m][1] * r));
                    *(u32x4*)(E.ob + (size_t)row * DFF + col) = (u32x4){lo.x, lo.y, hi.x, hi.y}; }
            } else {
                float ss = 0.f;
#pragma unroll
                for (int bj = 0; bj < 2; ++bj) { const int col = u.pn * BM + bj * HALF + wc * 32 + fq * 8;
                    const u32x4 rb = *(const u32x4*)(E.res + (size_t)row * 1024 + col);
                    const f32x4 x0 = (f32x4){bflo(rb.x), bfhi(rb.x), bflo(rb.y), bfhi(rb.y)} + acc[ai][bj][m][0];
                    const f32x4 x1 = (f32x4){bflo(rb.z), bfhi(rb.z), bflo(rb.w), bfhi(rb.w)} + acc[ai][bj][m][1]; ss += dot4(x0) + dot4(x1);
                    const u32x2 lo = pack4(x0), hi = pack4(x1);
                    *(u32x4*)(E.ob + (size_t)row * 1024 + col) = (u32x4){lo.x, lo.y, hi.x, hi.y}; }
                ss = quad_sum(ss); if (fq == 0) E.stOut[(size_t)row * 16 + u.pn * 4 + wc] = ss;
            }
        }
        asm volatile("" ::: "memory");
    }
}


__device__ __forceinline__ void epi_final(f32x4 (&acc)[2][2][4][2], const Unit& u, int wr, int wc, int fr, int fq, const EpiArgs& E, LAS float* rt) {
    const int tid = threadIdx.x, lane = tid & 63, wid = __builtin_amdgcn_readfirstlane(tid >> 6);
    const int rowb = u.pm * BM + wr * 64 + fr;
#pragma unroll
    for (int ai = 0; ai < 2; ++ai) {
#pragma unroll
        for (int m = 0; m < 4; ++m) {
            const int row = rowb + ai * HALF + m * 16; float ss = 0.f;
#pragma unroll
            for (int bj = 0; bj < 2; ++bj) { const int col = u.pn * BM + bj * HALF + wc * 32 + fq * 8;
                const u32x4 rb = *(const u32x4*)(E.res + (size_t)row * 1024 + col);
                acc[ai][bj][m][0] += (f32x4){bflo(rb.x), bfhi(rb.x), bflo(rb.y), bfhi(rb.y)};
                acc[ai][bj][m][1] += (f32x4){bflo(rb.z), bfhi(rb.z), bflo(rb.w), bfhi(rb.w)};
                ss += dot4(acc[ai][bj][m][0]) + dot4(acc[ai][bj][m][1]); }
            ss = quad_sum(ss);
            if (fq == 0) __hip_atomic_store((unsigned*)E.stOut + (size_t)row * 16 + u.pn * 4 + wc, __float_as_uint(ss), __ATOMIC_RELAXED, __HIP_MEMORY_SCOPE_AGENT);
        }
        asm volatile("" ::: "memory");
    }
    asm volatile("s_waitcnt vmcnt(0)" ::: "memory");
    unsigned* cw = E.cnt + 64 * u.pm;
    if (lane == 0) __hip_atomic_fetch_add(cw, 1u, __ATOMIC_RELAXED, __HIP_MEMORY_SCOPE_AGENT);
    if (E.scnt && blockIdx.x * 8 < MS) {
        if (wid == 0) { unsigned sp = 0;
            while ((unsigned)__builtin_amdgcn_readfirstlane(__hip_atomic_load(E.scnt, __ATOMIC_RELAXED, __HIP_MEMORY_SCOPE_AGENT)) < 8u * 128u) { __builtin_amdgcn_s_sleep(2); if (++sp > (1u << 20)) break; } }
        __syncthreads();
        const int srow = MP + blockIdx.x * 8 + wid;
        float s = __uint_as_float(__hip_atomic_load((const unsigned*)E.stOut + (size_t)srow * 16 + (lane & 15), __ATOMIC_RELAXED, __HIP_MEMORY_SCOPE_AGENT));
        s += __shfl_xor(s, 1); s += __shfl_xor(s, 2); s += __shfl_xor(s, 4); s += __shfl_xor(s, 8);
        const float sr = rsqrtf(s * (1.0f / 1024.0f) + EPS);
        const unsigned long long* sxb = (const unsigned long long*)(E.res + (size_t)srow * 1024);
#pragma unroll
        for (int i = 0; i < 4; ++i) { const int c = i * 256 + lane * 4; const unsigned long long q = __hip_atomic_load(sxb + (c >> 2), __ATOMIC_RELAXED, __HIP_MEMORY_SCOPE_AGENT);
            const unsigned qx = (unsigned)q, qy = (unsigned)(q >> 32); const f32x4 v = {bflo(qx), bfhi(qx), bflo(qy), bfhi(qy)};
            const f32x4 gg = *(const f32x4*)(E.gfin + c); *(f32x4*)(E.yout + (size_t)srow * 1024 + c) = v * sr * gg; }
    }
    if (wid == 0) {
        unsigned sp = 0;
        while ((unsigned)__builtin_amdgcn_readfirstlane(__hip_atomic_load(cw, __ATOMIC_RELAXED, __HIP_MEMORY_SCOPE_AGENT)) < 32u) { __builtin_amdgcn_s_sleep(2); if (++sp > (1u << 20)) break; }
    }
    __syncthreads();
    if (tid < 256) { const unsigned* sp = (const unsigned*)E.stOut + (size_t)(u.pm * BM + tid) * 16; float s = 0.f;
#pragma unroll
        for (int j = 0; j < 16; ++j) s += __uint_as_float(__hip_atomic_load(sp + j, __ATOMIC_RELAXED, __HIP_MEMORY_SCOPE_AGENT));
        rt[tid] = rsqrtf(s * (1.0f / 1024.0f) + EPS); }
    __syncthreads();
#pragma unroll
    for (int ai = 0; ai < 2; ++ai)
#pragma unroll
        for (int m = 0; m < 4; ++m) { const int row = rowb + ai * HALF + m * 16; const float r = rt[ai * HALF + wr * 64 + m * 16 + fr];
#pragma unroll
            for (int bj = 0; bj < 2; ++bj) { const int col = u.pn * BM + bj * HALF + wc * 32 + fq * 8;
                const f32x4 g0 = *(const f32x4*)(E.gfin + col), g1 = *(const f32x4*)(E.gfin + col + 4);
                __builtin_nontemporal_store(acc[ai][bj][m][0] * r * g0, (f32x4*)(E.yout + (size_t)row * 1024 + col));
                __builtin_nontemporal_store(acc[ai][bj][m][1] * r * g1, (f32x4*)(E.yout + (size_t)row * 1024 + col + 4)); } }
}

template <int EK>
__device__ __forceinline__ void skinny_phase(LAS unsigned char* redbase, LAS float* sred, const bf16_t* A, const bf16_t* Bt, int N, int K, const EpiArgs& E);

template <int EK, int SK = -1>
__device__ __forceinline__ void gemm_phase(LAS unsigned char* lds, const bf16_t* A, const bf16_t* Bt, int nM, int N, int K, const EpiArgs& E) {
    const int tid = threadIdx.x, wid = __builtin_amdgcn_readfirstlane(tid >> 6), lane = tid & 63, wr = wid >> 2, wc = wid & 3, fr = lane & 15, fq = lane >> 4;
    const int nt = K / BK;
    SOrder S; S.init(nM, N, (int)gridDim.x, (int)blockIdx.x);
    LAS float* rtab = (LAS float*)(lds + RTAB_OFF);
    unsigned voffA[2], voffB[2];
#pragma unroll
    for (int i = 0; i < 2; ++i) { int R, C; stage_rc(tid * 16 + i * 8192, R, C); const int Rb = (R & ~31) + perm32(R & 31);
        voffA[i] = (unsigned)(R * K + C) * 2u; voffB[i] = (unsigned)(Rb * K + C) * 2u; }
    const size_t kstep = (size_t)(BK * 2);
    const size_t hstep = (size_t)HALF * K * 2;
    const size_t tstep = 2 * hstep;
    const unsigned ldsw = (unsigned)wid * 1024u;
    const int aoff = lds_byte(wr * 64 + fr, fq * 8), boff = lds_byte(wc * 32 + fr, fq * 8);
#define PG8_SA(b, h) (((b) * 2 + (h)) * HTB)
#define PG8_SB(b, h) ((4 + (b) * 2 + (h)) * HTB)
#define PG8_STAGE_(bufoff, gbase, voff) do { _Pragma("unroll") for (int _i = 0; _i < 2; ++_i) \
        __builtin_amdgcn_global_load_lds((const unsigned*)((const char*)(gbase) + voff[_i]), (LAS unsigned*)(lds + (bufoff) + ldsw + _i * 8192), 16, 0, 0); } while (0)
#define PG8_STAGEA(bufoff, gbase) PG8_STAGE_(bufoff, gbase, voffA)
#define PG8_STAGEB(bufoff, gbase) PG8_STAGE_(bufoff, gbase, voffB)
#define PG8_LDA(dst, b, h) do { _Pragma("unroll") for (int m = 0; m < 4; ++m) _Pragma("unroll") for (int k = 0; k < 2; ++k) dst[m][k] = *(const LAS bf16x8*)(lds + PG8_SA(b, h) + aoff + m * 2048 + k * 1024); } while (0)
#define PG8_LDB(dst, b, h) do { _Pragma("unroll") for (int n = 0; n < 2; ++n) _Pragma("unroll") for (int k = 0; k < 2; ++k) dst[n][k] = *(const LAS bf16x8*)(lds + PG8_SB(b, h) + boff + n * 2048 + k * 1024); } while (0)
#define PG8_MMA(ai, bj, At, Bt_) do { __builtin_amdgcn_s_setprio(1); _Pragma("unroll") for (int m = 0; m < 4; ++m) _Pragma("unroll") for (int n = 0; n < 2; ++n) _Pragma("unroll") for (int k = 0; k < 2; ++k) \
        acc[ai][bj][m][n] = __builtin_amdgcn_mfma_f32_16x16x32_bf16(Bt_[n][k], At[m][k], acc[ai][bj][m][n], 0, 0, 0); __builtin_amdgcn_s_setprio(0); } while (0)
#define PG8_WAIT_V(n) asm volatile("s_waitcnt vmcnt(" #n ")" ::: "memory")
#define PG8_WAIT_L(n) asm volatile("s_waitcnt lgkmcnt(" #n ")" ::: "memory")
#define PG8_BAR __builtin_amdgcn_s_barrier()
#define PG8_SCHED __builtin_amdgcn_sched_barrier(0)
    Unit cur, nxt; int ui = 0;
    if (!S.next(0, cur)) { if (SK >= 0) skinny_phase<(SK >= 0 ? SK : 0)>(lds + 32768, (LAS float*)(lds + SRED_OFF), A, Bt, N, K, E); return; }
    f32x4 acc[2][2][4][2];
#pragma unroll
    for (int a = 0; a < 2; ++a)
#pragma unroll
        for (int b = 0; b < 2; ++b)
#pragma unroll
            for (int m = 0; m < 4; ++m)
#pragma unroll
                for (int n = 0; n < 2; ++n) acc[a][b][m][n] = (f32x4){0.f, 0.f, 0.f, 0.f};
    bf16x8 At[4][2], B0[2][2], B1[2][2];
    const char* cA = (const char*)A + (size_t)cur.pm * tstep; const char* cB = (const char*)Bt + (size_t)cur.pn * tstep;
    PG8_STAGEB(PG8_SB(0, 0), cB); PG8_STAGEB(PG8_SB(0, 1), cB + hstep); PG8_STAGEA(PG8_SA(0, 0), cA); PG8_STAGEA(PG8_SA(0, 1), cA + hstep);
    f32x4 tq[4][4]; bool okq[4];
    if (EK != EK_RES && EK != EK_FINAL) {
#pragma unroll
        for (int j = 0; j < 4; ++j) { Unit uu; okq[j] = S.next((tid >> 8) + 2 * j, uu);
            if (okq[j]) { const f32x4* sp = (const f32x4*)(E.stIn + (size_t)(uu.pm * BM + (tid & 255)) * 16); tq[j][0] = sp[0]; tq[j][1] = sp[1]; tq[j][2] = sp[2]; tq[j][3] = sp[3]; } }
    }
    if (SK >= 0) skinny_phase<(SK >= 0 ? SK : 0)>(lds + 32768, (LAS float*)(lds + SRED_OFF), A, Bt, N, K, E);
    if (EK != EK_RES && EK != EK_FINAL) {
#pragma unroll
        for (int j = 0; j < 4; ++j) if (okq[j]) { const float s_ = (hsum4(tq[j][0]) + hsum4(tq[j][1])) + (hsum4(tq[j][2]) + hsum4(tq[j][3]));
            rtab[((tid >> 8) + 2 * j) * 256 + (tid & 255)] = rsqrtf(s_ * (1.0f / 1024.0f) + EPS); }
        __syncthreads();
    }
    if (wr == 1) PG8_BAR;
    PG8_WAIT_V(2); PG8_BAR;
    PG8_STAGEB(PG8_SB(1, 0), cB + kstep); PG8_STAGEA(PG8_SA(1, 0), cA + kstep); PG8_STAGEB(PG8_SB(1, 1), cB + hstep + kstep);
    PG8_WAIT_V(6); PG8_BAR;
    for (;;) {
        const bool has_next = S.next(ui + 1, nxt);
        const char* nA = has_next ? (const char*)A + (size_t)nxt.pm * tstep : cA; const char* nB = has_next ? (const char*)Bt + (size_t)nxt.pn * tstep : cB;
        for (int t = 0; t < nt; t += 2) {
            const bool last = (t == nt - 2);
            const char* a1 = cA + (size_t)(t + 1) * kstep;
            const char* a2 = last ? nA : cA + (size_t)(t + 2) * kstep; const char* b2 = last ? nB : cB + (size_t)(t + 2) * kstep;
            const char* a3 = a2 + kstep; const char* b3 = b2 + kstep;
            PG8_LDB(B0, 0, 0); PG8_LDB(B1, 0, 1); PG8_SCHED; PG8_LDA(At, 0, 0); PG8_STAGEA(PG8_SA(1, 1), a1 + hstep);
            PG8_WAIT_V(8); PG8_WAIT_L(0); PG8_BAR; PG8_MMA(0, 0, At, B0); PG8_MMA(0, 1, At, B1); PG8_BAR; PG8_SCHED;
            PG8_LDA(At, 0, 1); PG8_STAGEB(PG8_SB(0, 0), b2); PG8_STAGEB(PG8_SB(0, 1), b2 + hstep); PG8_STAGEA(PG8_SA(0, 0), a2);
            PG8_WAIT_V(8); PG8_WAIT_L(0); PG8_BAR; PG8_MMA(1, 0, At, B0); PG8_MMA(1, 1, At, B1); PG8_BAR; PG8_SCHED;
            PG8_LDB(B0, 1, 0); PG8_LDB(B1, 1, 1); PG8_SCHED; PG8_LDA(At, 1, 0); PG8_STAGEA(PG8_SA(0, 1), a2 + hstep);
            PG8_WAIT_V(8); PG8_WAIT_L(0); PG8_BAR; PG8_MMA(0, 0, At, B0); PG8_MMA(0, 1, At, B1); PG8_BAR; PG8_SCHED;
            PG8_LDA(At, 1, 1); PG8_STAGEB(PG8_SB(1, 0), b3); PG8_STAGEB(PG8_SB(1, 1), b3 + hstep); PG8_STAGEA(PG8_SA(1, 0), a3);
            PG8_WAIT_V(8); PG8_WAIT_L(0); PG8_BAR; PG8_MMA(1, 0, At, B0); PG8_MMA(1, 1, At, B1); PG8_BAR; PG8_SCHED;
        }
        if (wr == 0) PG8_BAR;
        if (EK != EK_FINAL) epi_tile<EK>(acc, cur, wr, wc, fr, fq, E, rtab + ui * 256);
        if (!has_next) break;
#pragma unroll
        for (int a = 0; a < 2; ++a)
#pragma unroll
            for (int b = 0; b < 2; ++b)
#pragma unroll
                for (int m = 0; m < 4; ++m)
#pragma unroll
                    for (int n = 0; n < 2; ++n) acc[a][b][m][n] = (f32x4){0.f, 0.f, 0.f, 0.f};
        cur = nxt; cA = nA; cB = nB; ++ui;
        if (wr == 1) PG8_BAR;
    }
    PG8_WAIT_V(0);
    PG8_BAR;
    if (EK == EK_FINAL) epi_final(acc, cur, wr, wc, fr, fq, E, rtab);
#undef PG8_SA
#undef PG8_SB
#undef PG8_STAGE_
#undef PG8_STAGEA
#undef PG8_STAGEB
#undef PG8_LDA
#undef PG8_LDB
#undef PG8_MMA
#undef PG8_WAIT_V
#undef PG8_WAIT_L
#undef PG8_BAR
#undef PG8_SCHED
}

template <int EK>
__device__ __forceinline__ void skinny_phase(LAS unsigned char* redbase, LAS float* sred, const bf16_t* A, const bf16_t* Bt, int N, int K, const EpiArgs& E) {
    const int tid = threadIdx.x, wid = __builtin_amdgcn_readfirstlane(tid >> 6), lane = tid & 63, fr = lane & 15, fq = lane >> 4;
    LAS f32x4* red = (LAS f32x4*)redbase;
    const int ncg = (EK == EK_SWIGLU) ? (N / 64) : (N / 64);
    const int nbu = 8 * ncg;
    const int kw = K / 8, k0 = wid * kw;
    for (int bu = blockIdx.x; bu < nbu; bu += gridDim.x) {
        const int rg = bu & 7, cgp = bu >> 3;
        const int row = MP + rg * 16 + fr;
        int br0, br1, br2, br3;
        if (EK == EK_SWIGLU) { const int hc = cgp * 32; const int base = (hc >> 7) * 256 + (hc & 127); br0 = base; br1 = base + 16; br2 = base + 128; br3 = base + 144; }
        else { br0 = cgp * 64; br1 = br0 + 16; br2 = br0 + 32; br3 = br0 + 48; }
        const bf16_t* ap = A + (size_t)row * K + k0 + fq * 8;
        const bf16_t* bp0 = Bt + (size_t)(br0 + fr) * K + k0 + fq * 8;
        const bf16_t* bp1 = Bt + (size_t)(br1 + fr) * K + k0 + fq * 8;
        const bf16_t* bp2 = Bt + (size_t)(br2 + fr) * K + k0 + fq * 8;
        const bf16_t* bp3 = Bt + (size_t)(br3 + fr) * K + k0 + fq * 8;
        f32x4 a0 = {0.f, 0.f, 0.f, 0.f}, a1 = a0, a2 = a0, a3 = a0;
        f32x4 stq = {0.f, 0.f, 0.f, 0.f};
        if (EK != EK_RES && wid < 4) stq = *(const f32x4*)(E.stIn + (size_t)row * 16 + fq * 4);
        u32x2 rpre = {0u, 0u};
        if (EK == EK_RES && wid < 4) rpre = *(const u32x2*)(E.res + (size_t)row * 1024 + cgp * 64 + wid * 16 + fq * 4);
#pragma unroll 4
        for (int k = 0; k < kw; k += 32) {
            const bf16x8 a = *(const bf16x8*)(ap + k);
            const bf16x8 b0 = *(const bf16x8*)(bp0 + k), b1 = *(const bf16x8*)(bp1 + k), b2 = *(const bf16x8*)(bp2 + k), b3 = *(const bf16x8*)(bp3 + k);
            a0 = __builtin_amdgcn_mfma_f32_16x16x32_bf16(b0, a, a0, 0, 0, 0);
            a1 = __builtin_amdgcn_mfma_f32_16x16x32_bf16(b1, a, a1, 0, 0, 0);
            a2 = __builtin_amdgcn_mfma_f32_16x16x32_bf16(b2, a, a2, 0, 0, 0);
            a3 = __builtin_amdgcn_mfma_f32_16x16x32_bf16(b3, a, a3, 0, 0, 0);
        }
        red[(wid * 4 + 0) * 64 + lane] = a0; red[(wid * 4 + 1) * 64 + lane] = a1; red[(wid * 4 + 2) * 64 + lane] = a2; red[(wid * 4 + 3) * 64 + lane] = a3;
        __syncthreads();
        float ss = 0.f;
        if (wid < 4) {
            float r = 1.f;
            if (EK != EK_RES) { const float s = quad_sum(hsum4(stq)); r = rsqrtf(s * (1.0f / 1024.0f) + EPS); }
            if (EK == EK_SWIGLU) {
                if (wid < 2) {
                    f32x4 g = red[wid * 64 + lane], uu = red[(wid + 2) * 64 + lane];
#pragma unroll
                    for (int ww = 1; ww < 8; ++ww) { g += red[(ww * 4 + wid) * 64 + lane]; uu += red[(ww * 4 + wid + 2) * 64 + lane]; }
                    const int col = cgp * 32 + wid * 16 + fq * 4;
                    *(u32x2*)(E.ob + (size_t)row * DFF + col) = pack4(swiglu4(g * r, uu * r));
                }
            } else {
                f32x4 v = red[wid * 64 + lane];
#pragma unroll
                for (int ww = 1; ww < 8; ++ww) v += red[(ww * 4 + wid) * 64 + lane];
                const int col = cgp * 64 + wid * 16 + fq * 4;
                if (EK == EK_SCALE) { *(u32x2*)(E.ob + (size_t)row * E.ldb + col) = pack4(v * r); }
                else if (EK == EK_GELU) { const f32x4 z = gelu4(v * r); ss = dot4(z); *(u32x2*)(E.ob + (size_t)row * E.ldb + col) = pack4(z); }
                else { const u32x2 rb = rpre;
                    const f32x4 x = (f32x4){bflo(rb.x), bfhi(rb.x), bflo(rb.y), bfhi(rb.y)} + v; ss = dot4(x);
                    const u32x2 pk = pack4(x);
                    if (E.scnt) __hip_atomic_store((unsigned long long*)(E.ob + (size_t)row * 1024 + col), ((unsigned long long)pk.y << 32) | pk.x, __ATOMIC_RELAXED, __HIP_MEMORY_SCOPE_AGENT);
                    else *(u32x2*)(E.ob + (size_t)row * 1024 + col) = pk; }
            }
            if (EK == EK_RES || EK == EK_GELU) { ss = quad_sum(ss); if (fq == 0) sred[wid * 16 + fr] = ss; }
        }
        __syncthreads();
        if (EK == EK_RES || EK == EK_GELU) {
            if (tid < 16) { const float tot = (sred[tid] + sred[16 + tid]) + (sred[32 + tid] + sred[48 + tid]);
                if (EK == EK_RES) { if (E.scnt) __hip_atomic_store((unsigned*)E.stOut + (size_t)(MP + rg * 16 + tid) * 16 + cgp, __float_as_uint(tot), __ATOMIC_RELAXED, __HIP_MEMORY_SCOPE_AGENT);
                    else E.stOut[(size_t)(MP + rg * 16 + tid) * 16 + cgp] = tot; }
                else if (cgp >= 16) E.stOut[(size_t)(MP + rg * 16 + tid) * 16 + (cgp - 16)] = tot; }
            __syncthreads();
        }
        if (EK == EK_RES && E.scnt) {
            asm volatile("s_waitcnt vmcnt(0)" ::: "memory");
            if (lane == 0) __hip_atomic_fetch_add(E.scnt, 1u, __ATOMIC_RELAXED, __HIP_MEMORY_SCOPE_AGENT);
        }
    }
}

constexpr int NT_L0 = 724, NT_ALL = 1444, NT_WS = 32;
#define WJOB_DECODE(t_, src, dst, gain, K, N, k0, n0, drow0) do { \
        const int L_ = (t_) >= NT_L0; int tt_ = L_ ? (t_) - NT_L0 : (t_); int mode_ = 0; gain = nullptr; \
        if (tt_ < 128)      { src = L_ ? p.in[12] : p.in[7]; dst = (bf16_t*)(p.ws + (L_ ? OFF_W_INO : OFF_W_INE)); gain = p.in[4] + L_ * 1024; K = 1024; N = 2048; } \
        else if (tt_ < 192) { tt_ -= 128; src = L_ ? p.in[16] : p.in[11]; dst = (bf16_t*)(p.ws + (L_ ? OFF_W_OUTO : OFF_W_OUTE)); K = 1024; N = 1024; } \
        else if (tt_ < 368) { tt_ -= 192; src = p.in[17] + (size_t)L_ * 1024 * DFF; dst = (bf16_t*)(p.ws + (L_ ? OFF_W_GU1 : OFF_W_GU0)); gain = p.in[5] + L_ * 1024; K = 1024; N = DFF; mode_ = 1; } \
        else if (tt_ < 544) { tt_ -= 368; src = p.in[18] + (size_t)L_ * 1024 * DFF; dst = (bf16_t*)(p.ws + (L_ ? OFF_W_GU1 : OFF_W_GU0)); gain = p.in[5] + L_ * 1024; K = 1024; N = DFF; mode_ = 2; } \
        else if (tt_ < 720) { tt_ -= 544; src = p.in[19] + (size_t)L_ * DFF * 1024; dst = (bf16_t*)(p.ws + (L_ ? OFF_W_DN1 : OFF_W_DN0)); K = DFF; N = 1024; } \
        else { const int g_ = tt_ - 720; src = p.in[8] + (size_t)g_ * 16384; dst = (bf16_t*)(p.ws + OFF_W_POOL) + (size_t)g_ * 16384; K = 128; N = 128; tt_ = 0; } \
        const int ntn_ = N >> 7; k0 = (tt_ / ntn_) * 128; n0 = (tt_ % ntn_) * 128; \
        drow0 = mode_ ? ((n0 >> 7) * 256 + (mode_ == 2 ? 128 : 0)) : n0; } while (0)
__device__ __forceinline__ void prep_tiles(const Params& p, LAS unsigned char* lds, int t_first, int t_end, int stride) {
    const int tid = threadIdx.x;
    LAS float* tl = (LAS float*)lds;
    f32x4 pf[8];
    if (t_first < t_end) { const float* src; bf16_t* dst; const float* gain; int K, N, k0, n0, drow0; WJOB_DECODE(t_first, src, dst, gain, K, N, k0, n0, drow0);
        (void)dst; (void)gain; (void)K; (void)drow0;
#pragma unroll
        for (int i = 0; i < 8; ++i) { const int e = tid + 512 * i; pf[i] = ldnt((const f32x4*)(src + (size_t)(k0 + (e >> 5)) * N + n0 + (e & 31) * 4)); } }
    for (int t = t_first; t < t_end; t += stride) {
        f32x4 cf[8];
#pragma unroll
        for (int i = 0; i < 8; ++i) cf[i] = pf[i];
        if (t + stride < t_end) { const float* src; bf16_t* dst; const float* gain; int K, N, k0, n0, drow0; WJOB_DECODE(t + stride, src, dst, gain, K, N, k0, n0, drow0);
            (void)dst; (void)gain; (void)K; (void)drow0;
#pragma unroll
            for (int i = 0; i < 8; ++i) { const int e = tid + 512 * i; pf[i] = ldnt((const f32x4*)(src + (size_t)(k0 + (e >> 5)) * N + n0 + (e & 31) * 4)); } }
#pragma unroll
        for (int i = 0; i < 8; ++i) { const int e = tid + 512 * i, kk = e >> 5, n4 = (e & 31) * 4;
            tl[kk * 129 + n4 + 0] = cf[i][0]; tl[kk * 129 + n4 + 1] = cf[i][1]; tl[kk * 129 + n4 + 2] = cf[i][2]; tl[kk * 129 + n4 + 3] = cf[i][3]; }
        LDS_BARRIER();
        { const float* src; bf16_t* dst; const float* gain; int K, N, k0, n0, drow0; WJOB_DECODE(t, src, dst, gain, K, N, k0, n0, drow0); (void)src; (void)N; (void)n0;
            const int nn = tid >> 2, a8 = (tid & 3) * 8;
#pragma unroll
            for (int q = 0; q < 4; ++q) { const int kb = a8 + 32 * q; float v[8];
#pragma unroll
                for (int j = 0; j < 8; ++j) v[j] = tl[(kb + j) * 129 + nn];
                if (gain) { const f32x4 g0 = *(const f32x4*)(gain + k0 + kb), g1 = *(const f32x4*)(gain + k0 + kb + 4);
                    v[0] *= g0[0]; v[1] *= g0[1]; v[2] *= g0[2]; v[3] *= g0[3]; v[4] *= g1[0]; v[5] *= g1[1]; v[6] *= g1[2]; v[7] *= g1[3]; }
                u32x4 w; w.x = cvt_pk_bf16(v[0], v[1]); w.y = cvt_pk_bf16(v[2], v[3]); w.z = cvt_pk_bf16(v[4], v[5]); w.w = cvt_pk_bf16(v[6], v[7]);
                *(u32x4*)(dst + (size_t)(drow0 + nn) * K + k0 + kb) = w; } }
        LDS_BARRIER();
    }
}
__device__ __forceinline__ void prep_ws(const Params& p, int u_first, int stride) {
    const int tid = threadIdx.x;
    for (int u = u_first; u < NT_WS; u += stride) {
        const int base = u * 4096 + tid * 8;
        const int s0 = base & 127, tq = (base >> 7) & 127;
        const f32x4 v0 = *(const f32x4*)(p.in[14] + base), v1 = *(const f32x4*)(p.in[14] + base + 4);
        float v[8] = {v0[0], v0[1], v0[2], v0[3], v1[0], v1[1], v1[2], v1[3]};
#pragma unroll
        for (int j = 0; j < 8; ++j) if (s0 + j > tq) v[j] = 0.f;
        u32x4 w; w.x = cvt_pk_bf16(v[0], v[1]); w.y = cvt_pk_bf16(v[2], v[3]); w.z = cvt_pk_bf16(v[4], v[5]); w.w = cvt_pk_bf16(v[6], v[7]);
        *(u32x4*)((bf16_t*)(p.ws + OFF_W_WS) + base) = w;
    }
}
__device__ __forceinline__ void prep_phase(const Params& p, LAS unsigned char* lds) {
    const int tid = threadIdx.x, lane = tid & 63, wid = tid >> 6;
    prep_tiles(p, lds, blockIdx.x, NT_L0, gridDim.x);
    {
        const int gw = blockIdx.x * 8 + wid, nw = gridDim.x * 8;
        f32x4 xv[4];
        if (gw < MTOT) { const float* xs = gw < MP ? p.in[0] + (size_t)gw * 1024 : p.in[1] + (size_t)(gw - MP) * 1024;
#pragma unroll
            for (int i = 0; i < 4; ++i) xv[i] = ldnt((const f32x4*)(xs + i * 256 + lane * 4)); }
        for (int row = gw; row < MTOT; row += nw) {
            f32x4 cv[4];
#pragma unroll
            for (int i = 0; i < 4; ++i) cv[i] = xv[i];
            const int nr = row + nw;
            if (nr < MTOT) { const float* xs = nr < MP ? p.in[0] + (size_t)nr * 1024 : p.in[1] + (size_t)(nr - MP) * 1024;
#pragma unroll
                for (int i = 0; i < 4; ++i) xv[i] = ldnt((const f32x4*)(xs + i * 256 + lane * 4)); }
            bf16_t* xb = (bf16_t*)(p.ws + OFF_XB) + (size_t)row * 1024;
            float ss = 0.f;
#pragma unroll
            for (int i = 0; i < 4; ++i) { ss += dot4(cv[i]); *(u32x2*)(xb + i * 256 + lane * 4) = pack4(cv[i]); }
            ss = wave_sum(ss);
            if (lane < 16) ((float*)(p.ws + OFF_ST))[(size_t)row * 16 + lane] = lane == 0 ? ss : 0.f;
        }
    }
}

constexpr int DM_OFF = 79 * 128 * 4;
#define CONV_F(dst, x, c) do { dst[0] = bflo(x.x) * bflo(c.x); dst[1] = bfhi(x.x) * bfhi(c.x); dst[2] = bflo(x.y) * bflo(c.y); dst[3] = bfhi(x.y) * bfhi(c.y); \
    dst[4] = bflo(x.z) * bflo(c.z); dst[5] = bfhi(x.z) * bfhi(c.z); dst[6] = bflo(x.w) * bflo(c.w); dst[7] = bfhi(x.w) * bfhi(c.w); } while (0)
__device__ __forceinline__ void mixer_phase(const Params& p, LAS unsigned char* lds) {
    const int tid = threadIdx.x, wid = __builtin_amdgcn_readfirstlane(tid >> 6), lane = tid & 63, fr = lane & 15, fq = lane >> 4;
    const int bx = blockIdx.x, G = gridDim.x;
    const bf16_t* zb = (const bf16_t*)(p.ws + OFF_ZB);
    bf16_t* mix = (bf16_t*)(p.ws + OFF_MIXB);
    LAS float* P = (LAS float*)lds;
    LAS bf16_t* Dm = (LAS bf16_t*)(lds + DM_OFF);
    const int mt = wid & 3, nh = wid >> 2;
    int gcur = -1; bf16x8 wb[4][4]; f32x4 scv[4];
#define POOL_LOADW(g_) do { if ((g_) != gcur) { gcur = (g_); const bf16_t* wp = (const bf16_t*)(p.ws + OFF_W_POOL) + (size_t)gcur * 16384; \
        _Pragma("unroll") for (int ks = 0; ks < 4; ++ks) _Pragma("unroll") for (int nt = 0; nt < 4; ++nt) wb[ks][nt] = *(const bf16x8*)(wp + (size_t)(nh * 64 + (nt >> 1) * 32 + 8 * (fr >> 2) + 4 * (nt & 1) + (fr & 3)) * 128 + ks * 32 + fq * 8); \
        _Pragma("unroll") for (int nt = 0; nt < 4; ++nt) scv[nt] = *(const f32x4*)(p.in[9] + gcur * 128 + nh * 64 + (nt >> 1) * 32 + fq * 8 + (nt & 1) * 4); } } while (0)
#define POOL_MMA_STORE(g_, growbase) do { f32x4 acc[4]; _Pragma("unroll") for (int j = 0; j < 4; ++j) acc[j] = (f32x4){0.f, 0.f, 0.f, 0.f}; \
        _Pragma("unroll") for (int ks = 0; ks < 4; ++ks) { const bf16x8 a = *(const LAS bf16x8*)(Dm + (mt * 16 + fr) * 136 + ks * 32 + fq * 8); \
            _Pragma("unroll") for (int nt = 0; nt < 4; ++nt) acc[nt] = __builtin_amdgcn_mfma_f32_16x16x32_bf16(wb[ks][nt], a, acc[nt], 0, 0, 0); } \
        _Pragma("unroll") for (int k2 = 0; k2 < 2; ++k2) { const u32x2 lo_ = pack4(acc[2 * k2] * scv[2 * k2]), hi_ = pack4(acc[2 * k2 + 1] * scv[2 * k2 + 1]); \
            *(u32x4*)(mix + (size_t)((growbase) + mt * 16 + fr) * 1024 + (g_) * 128 + nh * 64 + k2 * 32 + fq * 8) = (u32x4){lo_.x, lo_.y, hi_.x, hi_.y}; } } while (0)
    u32x4 pq[3];
#define POOL_PREFETCH(uu) do { const int tt_ = (uu) >> 2, g_ = (uu) & 3, b_ = tt_ >> 5, t0_ = (tt_ & 31) * 64; \
        _Pragma("unroll") for (int i = 0; i < 3; ++i) { const int o = tid + 512 * i, rr = o >> 4, c8 = (o & 15) * 8, tpos = t0_ - 15 + rr; \
            pq[i] = (u32x4){0u, 0u, 0u, 0u}; if (o < 79 * 16 && tpos >= 0) pq[i] = ldnt((const u32x4*)(zb + (size_t)(b_ * T + tpos) * 2048 + g_ * 128 + c8)); } } while (0)
    if (bx < 1024) POOL_PREFETCH(bx);
    for (int tt = bx; tt < 256; tt += G) {
        const int b = tt >> 5, t0 = (tt & 31) * 64;
        const int c8 = (tid & 63) * 8, ts = t0 + (tid >> 6) * 8;
        float w0[8], w1[8], w2[8], f1[8], f2[8];
        { const float* cw = p.in[10] + c8;
            const f32x4 a0 = *(const f32x4*)(cw), a1 = *(const f32x4*)(cw + 4), b0 = *(const f32x4*)(cw + 512), b1 = *(const f32x4*)(cw + 516), c0 = *(const f32x4*)(cw + 1024), c1 = *(const f32x4*)(cw + 1028);
#pragma unroll
            for (int j = 0; j < 4; ++j) { w0[j] = a0[j]; w0[j + 4] = a1[j]; w1[j] = b0[j]; w1[j + 4] = b1[j]; w2[j] = c0[j]; w2[j + 4] = c1[j]; } }
#pragma unroll
        for (int j = 0; j < 8; ++j) { f1[j] = 0.f; f2[j] = 0.f; }
        if (ts >= 2) { const bf16_t* zr = zb + (size_t)(b * T + ts - 2) * 2048; const u32x4 x = *(const u32x4*)(zr + 512 + c8), c = *(const u32x4*)(zr + 1536 + c8); CONV_F(f2, x, c); }
        if (ts >= 1) { const bf16_t* zr = zb + (size_t)(b * T + ts - 1) * 2048; const u32x4 x = *(const u32x4*)(zr + 512 + c8), c = *(const u32x4*)(zr + 1536 + c8); CONV_F(f1, x, c); }
#pragma unroll
        for (int i = 0; i < 8; ++i) {
            const int t = ts + i; const bf16_t* zr = zb + (size_t)(b * T + t) * 2048;
            const u32x4 x = ldnt((const u32x4*)(zr + 512 + c8)), bg = ldnt((const u32x4*)(zr + 1024 + c8)), c = ldnt((const u32x4*)(zr + 1536 + c8));
            float f0[8], bgf[8], o[8];
            CONV_F(f0, x, c);
            bgf[0] = bflo(bg.x); bgf[1] = bfhi(bg.x); bgf[2] = bflo(bg.y); bgf[3] = bfhi(bg.y); bgf[4] = bflo(bg.z); bgf[5] = bfhi(bg.z); bgf[6] = bflo(bg.w); bgf[7] = bfhi(bg.w);
#pragma unroll
            for (int j = 0; j < 8; ++j) o[j] = bgf[j] * (f2[j] * w0[j] + f1[j] * w1[j] + f0[j] * w2[j]);
            u32x4 wv; wv.x = cvt_pk_bf16(o[0], o[1]); wv.y = cvt_pk_bf16(o[2], o[3]); wv.z = cvt_pk_bf16(o[4], o[5]); wv.w = cvt_pk_bf16(o[6], o[7]);
            *(u32x4*)(mix + (size_t)(b * T + t) * 1024 + 512 + c8) = wv;
            if (t >= T - 2) { float* so = p.out + OUT_CONVP + (size_t)(b * 2 + (t - (T - 2))) * 512 + c8;
                *(f32x4*)(so) = (f32x4){f0[0], f0[1], f0[2], f0[3]}; *(f32x4*)(so + 4) = (f32x4){f0[4], f0[5], f0[6], f0[7]}; }
#pragma unroll
            for (int j = 0; j < 8; ++j) { f2[j] = f1[j]; f1[j] = f0[j]; }
        }
    }
    for (int u = bx; u < 1024; u += G) {
        const int tt = u >> 2, g = u & 3, b = tt >> 5, t0 = (tt & 31) * 64, grow0 = b * T + t0, w = 2 << g;
        POOL_LOADW(g);
        u32x4 cp[3];
#pragma unroll
        for (int i = 0; i < 3; ++i) cp[i] = pq[i];
        if (u + G < 1024) POOL_PREFETCH(u + G);
#pragma unroll
        for (int i = 0; i < 3; ++i) { const int o = tid + 512 * i, rr = o >> 4, c8 = (o & 15) * 8;
            if (o < 79 * 16) { const u32x4 q = cp[i];
                *(LAS f32x4*)(P + rr * 128 + c8) = (f32x4){bflo(q.x), bfhi(q.x), bflo(q.y), bfhi(q.y)}; *(LAS f32x4*)(P + rr * 128 + c8 + 4) = (f32x4){bflo(q.z), bfhi(q.z), bflo(q.w), bfhi(q.w)}; } }
        LDS_BARRIER();
        { const int c = tid & 127, tl0 = (tid >> 7) * 16; const float invw = 1.0f / (float)w;
            float S = 0.f;
            for (int j = 1; j < w; ++j) S += P[(tl0 + 15 - j) * 128 + c];
#pragma unroll 4
            for (int i = 0; i < 16; ++i) { const int tl = tl0 + i; const float cur = P[(tl + 15) * 128 + c]; S += cur;
                const int pos = t0 + tl; const float inv = (pos + 1 >= w) ? invw : __builtin_amdgcn_rcpf((float)(pos + 1));
                Dm[tl * 136 + c] = f2bf(S * inv - cur);
                S -= P[(tl + 16 - w) * 128 + c]; }
        }
        if (t0 == T - 64) {
            for (int e = tid; e < 15 * 128; e += 512) { const int i = e >> 7, c = e & 127;
                p.out[OUT_POOLP + (size_t)(b * 15 + i) * 512 + g * 128 + c] = P[(64 + i) * 128 + c]; }
        }
        LDS_BARRIER();
        POOL_MMA_STORE(g, grow0);
    }
    for (int us = bx; us < 48; us += G) {
        if (us < 32) {
            const int g = us & 3, rb = us >> 2, w = 2 << g;
            POOL_LOADW(g);
            const int c = tid & 127, q = tid >> 7;
            float hv[4][15], pv[4];
#pragma unroll
            for (int i = 0; i < 4; ++i) { const int bs = rb * 16 + q * 4 + i; const float* hp = p.in[2] + (size_t)bs * 15 * 512 + g * 128 + c;
#pragma unroll
                for (int j = 0; j < 15; ++j) hv[i][j] = hp[j * 512];
                pv[i] = bf2f(zb[(size_t)(MP + bs) * 2048 + g * 128 + c]); }
            __syncthreads();
#pragma unroll
            for (int i = 0; i < 4; ++i) { const int bs = rb * 16 + q * 4 + i; float* so = p.out + OUT_POOLS + (size_t)bs * 15 * 512 + g * 128 + c;
                float S = pv[i];
#pragma unroll
                for (int j = 0; j < 15; ++j) { S += (j >= 16 - w) ? hv[i][j] : 0.f; if (j >= 1) so[(j - 1) * 512] = hv[i][j]; }
                so[14 * 512] = pv[i];
                Dm[(q * 4 + i) * 136 + c] = f2bf(S / (float)w - pv[i]); }
            __syncthreads();
            if (mt == 0) POOL_MMA_STORE(g, MP + rb * 16);
        } else {
            const int c8 = (tid & 63) * 8, bs = (us - 32) * 8 + (tid >> 6);
            const float* cw = p.in[10] + c8;
            f32x4 wq[3][2];
#pragma unroll
            for (int k = 0; k < 3; ++k) { wq[k][0] = *(const f32x4*)(cw + k * 512); wq[k][1] = *(const f32x4*)(cw + k * 512 + 4); }
            const bf16_t* zr = zb + (size_t)(MP + bs) * 2048;
            const u32x4 x = *(const u32x4*)(zr + 512 + c8), bg = *(const u32x4*)(zr + 1024 + c8), c = *(const u32x4*)(zr + 1536 + c8);
            const float* hp = p.in[3] + (size_t)bs * 2 * 512 + c8;
            f32x4 h0[2] = {*(const f32x4*)(hp), *(const f32x4*)(hp + 4)}, h1[2] = {*(const f32x4*)(hp + 512), *(const f32x4*)(hp + 516)};
            f32x4 f0[2], bgf[2];
            f0[0] = (f32x4){bflo(x.x) * bflo(c.x), bfhi(x.x) * bfhi(c.x), bflo(x.y) * bflo(c.y), bfhi(x.y) * bfhi(c.y)};
            f0[1] = (f32x4){bflo(x.z) * bflo(c.z), bfhi(x.z) * bfhi(c.z), bflo(x.w) * bflo(c.w), bfhi(x.w) * bfhi(c.w)};
            bgf[0] = (f32x4){bflo(bg.x), bfhi(bg.x), bflo(bg.y), bfhi(bg.y)}; bgf[1] = (f32x4){bflo(bg.z), bfhi(bg.z), bflo(bg.w), bfhi(bg.w)};
            float* so = p.out + OUT_CONVS + (size_t)bs * 2 * 512 + c8;
            u32x4 wv;
            { const f32x4 o = bgf[0] * (h0[0] * wq[0][0] + h1[0] * wq[1][0] + f0[0] * wq[2][0]); wv.x = cvt_pk_bf16(o[0], o[1]); wv.y = cvt_pk_bf16(o[2], o[3]); }
            { const f32x4 o = bgf[1] * (h0[1] * wq[0][1] + h1[1] * wq[1][1] + f0[1] * wq[2][1]); wv.z = cvt_pk_bf16(o[0], o[1]); wv.w = cvt_pk_bf16(o[2], o[3]); }
            *(u32x4*)(mix + (size_t)(MP + bs) * 1024 + 512 + c8) = wv;
            *(f32x4*)(so) = h1[0]; *(f32x4*)(so + 4) = h1[1]; *(f32x4*)(so + 512) = f0[0]; *(f32x4*)(so + 516) = f0[1];
        }
    }
#undef POOL_LOADW
#undef POOL_MMA_STORE
#undef POOL_PREFETCH
}

__device__ __forceinline__ void gating_phase(const Params& p, LAS unsigned char* lds) {
    const int tid = threadIdx.x, wid = __builtin_amdgcn_readfirstlane(tid >> 6), lane = tid & 63, fr = lane & 15, fq = lane >> 4;
    const int bx = blockIdx.x, G = gridDim.x;
    const bf16_t* zb = (const bf16_t*)(p.ws + OFF_ZB);
    bf16_t* mix = (bf16_t*)(p.ws + OFF_MIXB);
    const float* stv = (const float*)(p.ws + OFF_ST + 3 * ST_BYTES);
    const float* gv = p.in[13];
    LAS bf16_t* vT = (LAS bf16_t*)lds;
    u32x4 vq[4]; float stp[4]; u32x4 un[4];
    const int d8 = (tid & 15) * 8;
#define GATE_PREFETCH(uu_) do { const int h_ = (uu_) & 7, ch_ = ((uu_) >> 3) & 15, b_ = (uu_) >> 7, gr_ = b_ * T + ch_ * 128; \
        _Pragma("unroll") for (int i = 0; i < 4; ++i) { const int s_ = 2 * (tid >> 4) + 64 * (i >> 1) + (i & 1); \
            vq[i] = ldnt((const u32x4*)(zb + (size_t)(gr_ + s_) * 2048 + 1024 + h_ * 128 + d8)); stp[i] = stv[(size_t)(gr_ + s_) * 16 + (tid & 15)]; } \
        _Pragma("unroll") for (int k2 = 0; k2 < 4; ++k2) un[k2] = ldnt((const u32x4*)(zb + (size_t)(gr_ + wid * 16 + fr) * 2048 + h_ * 128 + k2 * 32 + fq * 8)); } while (0)
    if (bx < 1024) GATE_PREFETCH(bx);
    for (int wu = bx * 8 + wid; wu < 512; wu += G * 8) {
        const int bs = wu >> 2, row = MP + bs, c = (wu & 3) * 256 + lane * 4, h = c >> 7;
        float s = stv[(size_t)row * 16 + (lane & 15)];
        s += __shfl_xor(s, 1); s += __shfl_xor(s, 2); s += __shfl_xor(s, 4); s += __shfl_xor(s, 8);
        const float rv = rsqrtf(s * (1.0f / 1024.0f) + EPS);
        const u32x2 vv = *(const u32x2*)(zb + (size_t)row * 2048 + 1024 + c), uu = *(const u32x2*)(zb + (size_t)row * 2048 + c);
        const f32x4 g = *(const f32x4*)(gv + c);
        const f32x4 vn = (f32x4){bflo(vv.x), bfhi(vv.x), bflo(vv.y), bfhi(vv.y)} * rv * g;
        *(f32x4*)(p.out + OUT_SGV + (size_t)bs * 1024 + c) = vn;
        const float w00 = p.in[14][(size_t)h * 16384], b0 = p.in[15][h * 128];
        const f32x4 uf = {bflo(uu.x), bfhi(uu.x), bflo(uu.y), bfhi(uu.y)};
        *(u32x2*)(mix + (size_t)row * 1024 + c) = pack4(uf * (vn * w00 + b0));
    }
    int hcur = -1; bf16x8 af[4]; f32x4 g0, g1; float bias = 0.f;
    for (int u = bx; u < 1024; u += G) {
        const int h = u & 7, ch = (u >> 3) & 15, b = u >> 7, grow0 = b * T + ch * 128;
        if (h != hcur) { hcur = h; const bf16_t* wsb = (const bf16_t*)(p.ws + OFF_W_WS) + (size_t)h * 16384;
#pragma unroll
            for (int ks = 0; ks < 4; ++ks) af[ks] = *(const bf16x8*)(wsb + (size_t)(wid * 16 + fr) * 128 + ks * 32 + fq * 8);
            g0 = *(const f32x4*)(gv + h * 128 + d8); g1 = *(const f32x4*)(gv + h * 128 + d8 + 4); bias = p.in[15][h * 128 + wid * 16 + fr]; }
        u32x4 cq[4]; float cst[4]; u32x4 uc[4];
#pragma unroll
        for (int i = 0; i < 4; ++i) { cq[i] = vq[i]; cst[i] = stp[i]; }
#pragma unroll
        for (int k2 = 0; k2 < 4; ++k2) uc[k2] = un[k2];
        if (u + G < 1024) GATE_PREFETCH(u + G);
#pragma unroll
        for (int ip = 0; ip < 2; ++ip) {
            const int s0 = 2 * (tid >> 4) + 64 * ip;
            float sa = cst[2 * ip], sb = cst[2 * ip + 1];
            sa += __shfl_xor(sa, 1); sa += __shfl_xor(sa, 2); sa += __shfl_xor(sa, 4); sa += __shfl_xor(sa, 8);
            sb += __shfl_xor(sb, 1); sb += __shfl_xor(sb, 2); sb += __shfl_xor(sb, 4); sb += __shfl_xor(sb, 8);
            const float ra = rsqrtf(sa * (1.0f / 1024.0f) + EPS), rb = rsqrtf(sb * (1.0f / 1024.0f) + EPS);
            const u32x4 qa = cq[2 * ip], qb = cq[2 * ip + 1];
            const float va[8] = {bflo(qa.x) * ra * g0[0], bfhi(qa.x) * ra * g0[1], bflo(qa.y) * ra * g0[2], bfhi(qa.y) * ra * g0[3],
                                 bflo(qa.z) * ra * g1[0], bfhi(qa.z) * ra * g1[1], bflo(qa.w) * ra * g1[2], bfhi(qa.w) * ra * g1[3]};
            const float vb[8] = {bflo(qb.x) * rb * g0[0], bfhi(qb.x) * rb * g0[1], bflo(qb.y) * rb * g0[2], bfhi(qb.y) * rb * g0[3],
                                 bflo(qb.z) * rb * g1[0], bfhi(qb.z) * rb * g1[1], bflo(qb.w) * rb * g1[2], bfhi(qb.w) * rb * g1[3]};
#pragma unroll
            for (int j = 0; j < 8; ++j) {
                const int slot = (d8 & ~31) + (j >> 2) * 16 + ((d8 & 31) >> 3) * 4 + (j & 3);
                *(LAS unsigned*)(vT + slot * 136 + (s0 ^ (((slot >> 3) & 15) << 3))) = cvt_pk_bf16(va[j], vb[j]); }
        }
        LDS_BARRIER();
        f32x4 acc[8];
#pragma unroll
        for (int j = 0; j < 8; ++j) acc[j] = (f32x4){0.f, 0.f, 0.f, 0.f};
        const int nks = (wid >> 1) + 1;
#pragma unroll
        for (int ks = 0; ks < 4; ++ks) if (ks < nks) {
#pragma unroll
            for (int nt = 0; nt < 8; ++nt) { const int d = nt * 16 + fr; const int sw = (ks * 32 + fq * 8) ^ (((d >> 3) & 15) << 3);
                const bf16x8 bb = *(const LAS bf16x8*)(vT + d * 136 + sw);
                acc[nt] = __builtin_amdgcn_mfma_f32_16x16x32_bf16(bb, af[ks], acc[nt], 0, 0, 0); }
        }
        { bf16_t* orow = mix + (size_t)(grow0 + wid * 16 + fr) * 1024 + h * 128;
#pragma unroll
            for (int k2 = 0; k2 < 4; ++k2) { const u32x4 uu = uc[k2];
                const f32x4 u0 = {bflo(uu.x), bfhi(uu.x), bflo(uu.y), bfhi(uu.y)}, u1 = {bflo(uu.z), bfhi(uu.z), bflo(uu.w), bfhi(uu.w)};
                const u32x2 lo = pack4(u0 * (acc[2 * k2] + bias)), hi = pack4(u1 * (acc[2 * k2 + 1] + bias));
                *(u32x4*)(orow + k2 * 32 + fq * 8) = (u32x4){lo.x, lo.y, hi.x, hi.y}; } }
        LDS_BARRIER();
    }
#undef GATE_PREFETCH
}

__device__ __forceinline__ void final_phase(const Params& p, int row0) {
    const int tid = threadIdx.x, wid = tid >> 6, lane = tid & 63;
    const float* st = (const float*)(p.ws + OFF_ST + 5 * ST_BYTES);
    const float* g = p.in[6];
    for (int row = row0 + blockIdx.x * 8 + wid; row < MTOT; row += gridDim.x * 8) {
        const f32x4* sp = (const f32x4*)(st + (size_t)row * 16);
        const float s = (hsum4(sp[0]) + hsum4(sp[1])) + (hsum4(sp[2]) + hsum4(sp[3])); const float r = rsqrtf(s * (1.0f / 1024.0f) + EPS);
        float* xr = p.out + (size_t)row * 1024; const bf16_t* xb = (const bf16_t*)(p.ws + OFF_XB) + (size_t)row * 1024;
#pragma unroll
        for (int i = 0; i < 4; ++i) { const int c = i * 256 + lane * 4; const u32x2 q = *(const u32x2*)(xb + c); const f32x4 v = {bflo(q.x), bfhi(q.x), bflo(q.y), bfhi(q.y)};
            const f32x4 gg = *(const f32x4*)(g + c); *(f32x4*)(xr + c) = v * r * gg; }
    }
}

__device__ __forceinline__ void final_sample_fused(const Params& p, unsigned* scnt) {
    if (blockIdx.x * 8 >= MS) return;
    const int tid = threadIdx.x, wid = __builtin_amdgcn_readfirstlane(tid >> 6);
    if (wid == 0) { unsigned sp = 0;
        while ((unsigned)__builtin_amdgcn_readfirstlane(__hip_atomic_load(scnt, __ATOMIC_RELAXED, __HIP_MEMORY_SCOPE_AGENT)) < 8u * 128u) { __builtin_amdgcn_s_sleep(2); if (++sp > (1u << 20)) break; }
        __builtin_amdgcn_fence(__ATOMIC_ACQUIRE, "agent");
        asm volatile("s_waitcnt vmcnt(0)" ::: "memory"); }
    __syncthreads();
    final_phase(p, MP);
}

#define XB_TMO      128
#define XB_XCNT(j)  (256  + 64 * (j))
#define XB_XSUB(j)  (1280 + 64 * (j))
#define XB_XGEN(j)  (2304 + 64 * (j))
#define XB_TOP      3328
#define XB_TOPGEN   3392
#define XCD_BAR_WORDS 3456
#define XB_SPIN_CAP (1u << 18)
static_assert(XCD_BAR_WORDS * 4 <= 16384, "barrier words");
__device__ __forceinline__ unsigned xb_ld(unsigned* p)              { return __hip_atomic_load(p, __ATOMIC_RELAXED, __HIP_MEMORY_SCOPE_AGENT); }
__device__ __forceinline__ unsigned xb_add(unsigned* p, unsigned v) { return __hip_atomic_fetch_add(p, v, __ATOMIC_RELAXED, __HIP_MEMORY_SCOPE_AGENT); }
__device__ __forceinline__ unsigned xb_xcc_id() { return (unsigned)__builtin_amdgcn_s_getreg((3 << 11) | 20) & 0xFu; }
#define XB_SPIN(cond, bar) do { unsigned _sp = 0; while (cond) { __builtin_amdgcn_s_sleep(1); \
    if ((++_sp & 255u) == 0u) { if (xb_ld(&(bar)[XB_TMO])) break; if (_sp > XB_SPIN_CAP) { atomicAdd(&(bar)[XB_TMO], 1u); break; } } } } while (0)
struct XcdBarrier { unsigned* bar; unsigned x; volatile LAS unsigned* st; };
__device__ __forceinline__ XcdBarrier xcd_barrier_post(unsigned* bar, volatile LAS unsigned* st) {
    XcdBarrier b; b.bar = bar; b.x = xb_xcc_id(); b.st = st;
    if (threadIdx.x == 0) (void)xb_add(&bar[XB_XCNT(b.x)], 1u);
    return b;
}
__device__ __forceinline__ void xcd_barrier_complete(unsigned* bar, unsigned x, unsigned& nloc, unsigned& nx) {
    const unsigned G = gridDim.x * gridDim.y * gridDim.z;
    unsigned sum, cnt, mine, sp = 0u;
    for (;;) {
        sum = 0u; cnt = 0u; mine = 0u;
#pragma unroll
        for (unsigned j = 0; j < 16; ++j) { const unsigned c = xb_ld(&bar[XB_XCNT(j)]); sum += c; cnt += (c > 0u) ? 1u : 0u; mine = (j == x) ? c : mine; }
        if (sum == G) break;
        __builtin_amdgcn_s_sleep(1);
        if ((++sp & 255u) == 0u) { if (xb_ld(&bar[XB_TMO])) break; if (sp > XB_SPIN_CAP) { atomicAdd(&bar[XB_TMO], 1u); break; } }
    }
    nloc = mine > 0u ? mine : 1u; nx = cnt > 0u ? cnt : 1u;
}
__device__ __forceinline__ void xcd_barrier(const XcdBarrier& b) {
    if (threadIdx.x == 0 && b.st[0] == 0u) {
        unsigned nloc0, nx0; xcd_barrier_complete(b.bar, b.x, nloc0, nx0); b.st[0] = nloc0; b.st[1] = nx0; }
    asm volatile("s_waitcnt vmcnt(0)" ::: "memory");
    __syncthreads();
    if (threadIdx.x == 0) {
        unsigned* bar = b.bar;
        __builtin_amdgcn_s_waitcnt(0);
        unsigned nloc = b.st[0], nx = b.st[1];
        if (nloc == 0u) { xcd_barrier_complete(bar, b.x, nloc, nx); b.st[0] = nloc; b.st[1] = nx; }
        const unsigned old = xb_add(&bar[XB_XSUB(b.x)], 1u);
        const unsigned gen = old / nloc;
        if (old + 1u == (gen + 1u) * nloc) {
            __builtin_amdgcn_fence(__ATOMIC_RELEASE, "agent");
            asm volatile("s_waitcnt vmcnt(0)" ::: "memory");
            const unsigned og = xb_add(&bar[XB_TOP], 1u);
            const unsigned tg = og / nx;
            if (og + 1u == (tg + 1u) * nx) xb_add(&bar[XB_TOPGEN], 1u);
            else XB_SPIN(xb_ld(&bar[XB_TOPGEN]) == tg, bar);
            __builtin_amdgcn_fence(__ATOMIC_ACQUIRE, "agent");
            asm volatile("s_waitcnt vmcnt(0)" ::: "memory");
        } else {
            XB_SPIN(xb_ld(&bar[XB_TOPGEN]) == gen, bar);
            __builtin_amdgcn_fence(__ATOMIC_ACQUIRE, "agent");
            asm volatile("s_waitcnt vmcnt(0)" ::: "memory");
        }
    }
    __syncthreads();
}

__global__ void __launch_bounds__(512, 2) mega_fwd(Params p) {
    extern __shared__ __attribute__((aligned(16))) unsigned char lds_raw[];
    LAS unsigned char* lds = (LAS unsigned char*)lds_raw;
    const int lo = p.ph_lo, hi = p.ph_hi;
#define IN(k) (lo <= (k) && (k) < hi)
#define SEAM(k) do { if (IN(k) && IN((k) + 1)) xcd_barrier(bar); } while (0)
    unsigned char* ws = p.ws;
    volatile LAS unsigned* stw = (volatile LAS unsigned*)(lds + LDS_STAGE);
    if (threadIdx.x < 4) stw[threadIdx.x] = 0u;
    __syncthreads();
    XcdBarrier bar; bar.bar = (unsigned*)(ws + OFF_BAR); bar.x = 0; bar.st = stw;
    if (hi - lo > 1) bar = xcd_barrier_post((unsigned*)(ws + OFF_BAR), stw);
    bf16_t* XB = (bf16_t*)(ws + OFF_XB); bf16_t* ZB = (bf16_t*)(ws + OFF_ZB); bf16_t* MIXB = (bf16_t*)(ws + OFF_MIXB); bf16_t* HB = (bf16_t*)(ws + OFF_HB);
    float* ST0 = (float*)(ws + OFF_ST); float* ST1 = (float*)(ws + OFF_ST + ST_BYTES); float* ST2 = (float*)(ws + OFF_ST + 2 * ST_BYTES);
    float* STV = (float*)(ws + OFF_ST + 3 * ST_BYTES); float* ST3 = (float*)(ws + OFF_ST + 4 * ST_BYTES); float* ST4 = (float*)(ws + OFF_ST + 5 * ST_BYTES);

    if (IN(0)) { prep_phase(p, lds); } SEAM(0);
    if (IN(1)) { const EpiArgs E{ZB, 2048, nullptr, ST0, nullptr, nullptr, nullptr, nullptr, nullptr}; const bf16_t* W = (const bf16_t*)(ws + OFF_W_INE);
        gemm_phase<EK_SCALE, EK_SCALE>(lds, XB, W, 64, 2048, 1024, E); } SEAM(1);
    if (IN(2)) { mixer_phase(p, lds); } SEAM(2);
    if (IN(3)) { const EpiArgs E{XB, 1024, XB, nullptr, ST1, nullptr, nullptr, nullptr, nullptr}; const bf16_t* W = (const bf16_t*)(ws + OFF_W_OUTE);
        gemm_phase<EK_RES, EK_RES>(lds, MIXB, W, 64, 1024, 1024, E); } SEAM(3);
    if (IN(4)) { const EpiArgs E{HB, DFF, nullptr, ST1, nullptr, nullptr, nullptr, nullptr, nullptr}; const bf16_t* W = (const bf16_t*)(ws + OFF_W_GU0);
        gemm_phase<EK_SWIGLU>(lds, XB, W, 65  , 2 * DFF, 1024, E);
        {
            const int G_ = (int)gridDim.x, nwg_ = 65 * 22, busy_ = nwg_ - ((nwg_ - 1) / G_) * G_, c_ = (int)blockIdx.x;
            const int nidle_ = G_ - busy_;
            if (nidle_ == 0) { prep_tiles(p, lds, NT_L0 + c_, NT_ALL, G_); prep_ws(p, c_, G_); }
            else if (c_ >= busy_) { prep_tiles(p, lds, NT_L0 + (c_ - busy_), NT_ALL, nidle_); prep_ws(p, c_ - busy_, nidle_); }
        } } SEAM(4);
    if (IN(5)) { const EpiArgs E{XB, 1024, XB, nullptr, ST2, nullptr, nullptr, nullptr, nullptr}; const bf16_t* W = (const bf16_t*)(ws + OFF_W_DN0);
        gemm_phase<EK_RES, EK_RES>(lds, HB, W, 64, 1024, DFF, E); } SEAM(5);
    if (IN(6)) { const EpiArgs E{ZB, 2048, nullptr, ST2, STV, nullptr, nullptr, nullptr, nullptr}; const bf16_t* W = (const bf16_t*)(ws + OFF_W_INO);
        gemm_phase<EK_GELU, EK_GELU>(lds, XB, W, 64, 2048, 1024, E); } SEAM(6);
    if (IN(7)) { gating_phase(p, lds); } SEAM(7);
    if (IN(8)) { const EpiArgs E{XB, 1024, XB, nullptr, ST3, nullptr, nullptr, nullptr, nullptr}; const bf16_t* W = (const bf16_t*)(ws + OFF_W_OUTO);
        gemm_phase<EK_RES, EK_RES>(lds, MIXB, W, 64, 1024, 1024, E); } SEAM(8);
    if (IN(9)) { const EpiArgs E{HB, DFF, nullptr, ST3, nullptr, nullptr, nullptr, nullptr, nullptr}; const bf16_t* W = (const bf16_t*)(ws + OFF_W_GU1);
        gemm_phase<EK_SWIGLU>(lds, XB, W, 65  , 2 * DFF, 1024, E); } SEAM(9);
    const bool fuse_final = (gridDim.x == 256);
    if (IN(10)) { unsigned* scnt = (unsigned*)(ws + OFF_BAR) + 8192;
        const EpiArgs E{XB, 1024, XB, nullptr, ST4, p.out, p.in[6], (unsigned*)(ws + OFF_BAR) + 4096, fuse_final ? scnt : nullptr}; const bf16_t* W = (const bf16_t*)(ws + OFF_W_DN1);
        if (fuse_final) gemm_phase<EK_FINAL, EK_RES>(lds, HB, W, 64, 1024, DFF, E);
        else gemm_phase<EK_RES, EK_RES>(lds, HB, W, 64, 1024, DFF, E); }
    if (!fuse_final) { SEAM(10); if (IN(11)) final_phase(p, 0); }
#undef IN
#undef SEAM
}

extern "C" void kernel_launch(void* const* d_in, const int* in_sizes, int n_in, void* d_out, int out_size, void* d_ws, size_t ws_size, hipStream_t stream) {
    static int grid = 0;
    if (grid == 0) {
        if (n_in != 20 || ws_size < WS_END) { fprintf(stderr, "kernel_launch: unexpected n_in %d or ws_size %zu (need %zu)\n", n_in, ws_size, (size_t)WS_END); grid = -1; return; }
        int dev = 0, cus = 0, per_cu = 0;
        hipGetDevice(&dev);
        hipDeviceGetAttribute(&cus, hipDeviceAttributeMultiprocessorCount, dev);
        if (hipFuncSetAttribute((const void*)mega_fwd, hipFuncAttributeMaxDynamicSharedMemorySize, LDS_BYTES) != hipSuccess) { fprintf(stderr, "kernel_launch: hipFuncSetAttribute failed\n"); grid = -1; return; }
        if (hipOccupancyMaxActiveBlocksPerMultiprocessor(&per_cu, (const void*)mega_fwd, 512, LDS_BYTES) != hipSuccess || per_cu < 1) { fprintf(stderr, "kernel_launch: occupancy query gave %d\n", per_cu); per_cu = 1; }
        (void)hipGetLastError();
        grid = cus * (per_cu > 1 ? 1 : per_cu);
        if (grid <= 0) grid = 256;
    }
    if (grid < 0) return;
    Params p{};
    for (int i = 0; i < 20; ++i) p.in[i] = (const float*)d_in[i];
    p.out = (float*)d_out; p.ws = (unsigned char*)d_ws;
#if N_LAUNCHES == 1
    if (hipMemsetAsync((unsigned char*)d_ws + OFF_BAR, 0, BAR_BYTES, stream) != hipSuccess) { fprintf(stderr, "kernel_launch: memset of the barrier words failed\n"); return; }
    p.ph_lo = 0; p.ph_hi = NPHASE;
    void* args[] = {&p};
    hipError_t e = hipLaunchCooperativeKernel((const void*)mega_fwd, dim3(grid), dim3(512), args, LDS_BYTES, stream);
    if (e != hipSuccess) fprintf(stderr, "cooperative launch failed: %s (grid %d)\n", hipGetErrorString(e), grid);
#else
    for (int k = 0; k < NPHASE; ++k) {
        p.ph_lo = k; p.ph_hi = k + 1;
        hipLaunchKernelGGL(mega_fwd, dim3(grid), dim3(512), LDS_BYTES, stream, p);
    }
#endif
}
```

```cpp
#include <hip/hip_runtime.h>
#include <cstdio>

#ifndef N_LAUNCHES
#define N_LAUNCHES 1
#endif

#define LAS __attribute__((address_space(3)))
typedef unsigned short bf16_t;
typedef short bf16x8 __attribute__((ext_vector_type(8)));
typedef float f32x4 __attribute__((ext_vector_type(4)));
typedef float f32x2 __attribute__((ext_vector_type(2)));
typedef unsigned u32x4 __attribute__((ext_vector_type(4)));
typedef unsigned u32x2 __attribute__((ext_vector_type(2)));

constexpr int D = 1024, T = 2048, MP = 16384, MS = 128, MTOT = MP + MS, MPAD = MP + 256, DFF = 2816;
constexpr float EPS = 1e-6f;
constexpr int NPHASE = 12;
constexpr int LDS_STAGE = 131072;
constexpr int RTAB_OFF = LDS_STAGE + 16;
constexpr int SRED_OFF = RTAB_OFF + 8 * 256 * 4;
constexpr int LDS_BYTES = SRED_OFF + 256;

constexpr size_t OFF_W_INE = 0;
constexpr size_t OFF_W_OUTE = OFF_W_INE + 4194304;
constexpr size_t OFF_W_GU0 = OFF_W_OUTE + 2097152;
constexpr size_t OFF_W_DN0 = OFF_W_GU0 + 11534336;
constexpr size_t OFF_W_INO = OFF_W_DN0 + 5767168;
constexpr size_t OFF_W_OUTO = OFF_W_INO + 4194304;
constexpr size_t OFF_W_GU1 = OFF_W_OUTO + 2097152;
constexpr size_t OFF_W_DN1 = OFF_W_GU1 + 11534336;
constexpr size_t OFF_W_POOL = OFF_W_DN1 + 5767168;
constexpr size_t OFF_W_WS = OFF_W_POOL + 131072;
constexpr size_t OFF_XB = OFF_W_WS + 262144;
constexpr size_t OFF_ZB = OFF_XB + (size_t)MPAD * 1024 * 2;
constexpr size_t OFF_MIXB = OFF_ZB + (size_t)MTOT * 2048 * 2;
constexpr size_t OFF_ST = OFF_MIXB + (size_t)MTOT * 1024 * 2;
constexpr size_t ST_BYTES = (size_t)MPAD * 16 * 4;
constexpr size_t OFF_BAR = OFF_ST + 6 * ST_BYTES;
constexpr size_t BAR_BYTES = 65536;
constexpr size_t WS_END = OFF_BAR + BAR_BYTES;
constexpr size_t OFF_HB = OFF_ZB;
static_assert((size_t)MPAD * DFF * 2 <= (size_t)MTOT * 3072 * 2, "HB alias");

constexpr size_t OUT_Y = 0;
constexpr size_t OUT_POOLP = (size_t)MTOT * 1024;
constexpr size_t OUT_POOLS = OUT_POOLP + 8 * 15 * 512;
constexpr size_t OUT_CONVP = OUT_POOLS + 128 * 15 * 512;
constexpr size_t OUT_CONVS = OUT_CONVP + 8 * 2 * 512;
constexpr size_t OUT_SGV = OUT_CONVS + 128 * 2 * 512;

struct Params { const float* in[20]; float* out; unsigned char* ws; int ph_lo, ph_hi; };

#define LDS_BARRIER() do { asm volatile("s_waitcnt lgkmcnt(0)" ::: "memory"); __builtin_amdgcn_s_barrier(); asm volatile("" ::: "memory"); } while (0)
__device__ __forceinline__ unsigned cvt_pk_bf16(float lo, float hi) { unsigned r; asm("v_cvt_pk_bf16_f32 %0, %1, %2" : "=v"(r) : "v"(lo), "v"(hi)); return r; }
__device__ __forceinline__ bf16_t f2bf(float f) { unsigned u = __float_as_uint(f); u += 0x7FFFu + ((u >> 16) & 1u); return (bf16_t)(u >> 16); }
__device__ __forceinline__ float bf2f(bf16_t b) { return __uint_as_float(((unsigned)b) << 16); }
__device__ __forceinline__ float bflo(unsigned u) { return __uint_as_float(u << 16); }
__device__ __forceinline__ float bfhi(unsigned u) { return __uint_as_float(u & 0xffff0000u); }
__device__ __forceinline__ float hsum4(f32x4 v) { return (v[0] + v[1]) + (v[2] + v[3]); }
__device__ __forceinline__ float dot4(f32x4 v) { return (v[0] * v[0] + v[1] * v[1]) + (v[2] * v[2] + v[3] * v[3]); }
__device__ __forceinline__ u32x2 pack4(f32x4 v) { u32x2 w; w.x = cvt_pk_bf16(v[0], v[1]); w.y = cvt_pk_bf16(v[2], v[3]); return w; }
__device__ __forceinline__ f32x4 ldnt(const f32x4* p) { return __builtin_nontemporal_load(p); }
__device__ __forceinline__ u32x4 ldnt(const u32x4* p) { return __builtin_nontemporal_load(p); }
__device__ __forceinline__ float wave_sum(float s) { s += __shfl_xor(s, 1); s += __shfl_xor(s, 2); s += __shfl_xor(s, 4); s += __shfl_xor(s, 8); s += __shfl_xor(s, 16); s += __shfl_xor(s, 32); return s; }
__device__ __forceinline__ float quad_sum(float s) { s += __shfl_xor(s, 16); s += __shfl_xor(s, 32); return s; }

__device__ __forceinline__ f32x2 gelu_pk(f32x2 v) {
    const f32x2 av = __builtin_elementwise_abs(v), d = av * 0.2316418882f + 1.0f;
    f32x2 t; t.x = __builtin_amdgcn_rcpf(d.x); t.y = __builtin_amdgcn_rcpf(d.y);
    f32x2 q = t * 0.5307027145f + (-0.7265760135f); q = q * t + 0.7107068705f; q = q * t + (-0.142248368f); q = q * t + 0.127414796f; q = q * t;
    const f32x2 s = (v * v) * (-0.72134752044f);
    f32x2 e; e.x = __builtin_amdgcn_exp2f(s.x); e.y = __builtin_amdgcn_exp2f(s.y);
    const f32x2 m = v * (q * e), r = v - m;
    f32x2 o; o.x = v.x < 0.f ? m.x : r.x; o.y = v.y < 0.f ? m.y : r.y; return o;
}
__device__ __forceinline__ f32x4 gelu4(f32x4 v) { f32x2 a = gelu_pk((f32x2){v[0], v[1]}), b = gelu_pk((f32x2){v[2], v[3]}); return (f32x4){a.x, a.y, b.x, b.y}; }
__device__ __forceinline__ float silu1(float g) { return g * __builtin_amdgcn_rcpf(1.0f + __expf(-g)); }
__device__ __forceinline__ f32x4 swiglu4(f32x4 g, f32x4 u) { return (f32x4){silu1(g[0]) * u[0], silu1(g[1]) * u[1], silu1(g[2]) * u[2], silu1(g[3]) * u[3]}; }

constexpr int BM = 256, BK = 64, HALF = 128, HTB = HALF * BK * 2, NXCD = 8, WGM = 4;
__device__ __forceinline__ int lds_byte(int r, int c) { const int st = (r >> 4) * 2 + (c >> 5), rr = r & 15, cc = c & 31, ob = rr * 64 + cc * 2; return st * 1024 + (ob ^ (((ob >> 9) & 1) << 5)); }
__device__ __forceinline__ void stage_rc(int b, int& R, int& C) { const int st = b / 1024, sb = b % 1024, swz = sb ^ (((sb >> 9) & 1) << 5); R = (st >> 1) * 16 + swz / 64; C = (st & 1) * 32 + (swz % 64) / 2; }

__device__ __forceinline__ int perm32(int rho) { const int n = rho >> 4, i = rho & 15; return 8 * (i >> 2) + 4 * n + (i & 3); }
struct Unit { int pm, pn; };
struct SOrder {
    int nM, nN, nwg, G, c;
    __device__ __forceinline__ void init(int nM_, int N, int G_, int c_) { nM = nM_; nN = N / BM; nwg = nM * nN; G = G_; c = c_; }
    __device__ __forceinline__ bool next(int i, Unit& u) const {
        const long L = (long)i * G + c; if (L >= nwg) return false;
        int wgid = (int)L; { const int q = nwg / NXCD, r = nwg % NXCD, xcd = wgid % NXCD, off = wgid / NXCD; wgid = (xcd < r ? xcd * (q + 1) : r * (q + 1) + (xcd - r) * q) + off; }
        const int nig = WGM * nN, gid = wgid / nig, fm = gid * WGM, gsz = (nM - fm) < WGM ? (nM - fm) : WGM;
        u.pm = fm + ((wgid % nig) % gsz); u.pn = (wgid % nig) / gsz; return true;
    }
};

enum { EK_SCALE = 0, EK_RES = 1, EK_SWIGLU = 2, EK_GELU = 3, EK_FINAL = 4 };
struct EpiArgs {
    bf16_t* ob; int ldb;
    const bf16_t* res;
    const float* stIn;
    float* stOut;
    float* yout;
    const float* gfin;
    unsigned* cnt;
    unsigned* scnt;
};

template <int EK>
__device__ __forceinline__ void epi_tile(const f32x4 (&acc)[2][2][4][2], const Unit& u, int wr, int wc, int fr, int fq, const EpiArgs& E, const LAS float* rt) {
    const int rowb = u.pm * BM + wr * 64 + fr;
    float rr[2][4];
    if (EK != EK_RES) {
#pragma unroll
        for (int ai = 0; ai < 2; ++ai)
#pragma unroll
            for (int m = 0; m < 4; ++m) rr[ai][m] = rt[ai * HALF + wr * 64 + m * 16 + fr];
    }
#pragma unroll
    for (int ai = 0; ai < 2; ++ai) {
#pragma unroll
        for (int m = 0; m < 4; ++m) {
            const int row = rowb + ai * HALF + m * 16;
            if (EK == EK_SCALE) {
                const float r = rr[ai][m];
#pragma unroll
                for (int bj = 0; bj < 2; ++bj) { const int col = u.pn * BM + bj * HALF + wc * 32 + fq * 8;
                    const u32x2 lo = pack4(acc[ai][bj][m][0] * r), hi = pack4(acc[ai][bj][m][1] * r);
                    *(u32x4*)(E.ob + (size_t)row * E.ldb + col) = (u32x4){lo.x, lo.y, hi.x, hi.y}; }
            } else if (EK == EK_GELU) {
                const float r = rr[ai][m]; float ss = 0.f;
#pragma unroll
                for (int bj = 0; bj < 2; ++bj) { const int col = u.pn * BM + bj * HALF + wc * 32 + fq * 8;
                    const f32x4 z0 = gelu4(acc[ai][bj][m][0] * r), z1 = gelu4(acc[ai][bj][m][1] * r); ss += dot4(z0) + dot4(z1);
                    const u32x2 lo = pack4(z0), hi = pack4(z1);
                    *(u32x4*)(E.ob + (size_t)row * E.ldb + col) = (u32x4){lo.x, lo.y, hi.x, hi.y}; }
                if (u.pn >= 4) { ss = quad_sum(ss); if (fq == 0) E.stOut[(size_t)row * 16 + (u.pn - 4) * 4 + wc] = ss; }
            } else if (EK == EK_SWIGLU) {
                const float r = rr[ai][m];
                { const int col = u.pn * HALF + wc * 32 + fq * 8;
                    const u32x2 lo = pack4(swiglu4(acc[ai][0][m][0] * r, acc[ai][1][m][0] * r)), hi = pack4(swiglu4(acc[ai][0][m][1] * r, acc[ai][1][m][1] * r));
                    *(u32x4*)(E.ob + (size_t)row * DFF + col) = (u32x4){lo.x, lo.y, hi.x, hi.y}; }
            } else {
                float ss = 0.f;
#pragma unroll
                for (int bj = 0; bj < 2; ++bj) { const int col = u.pn * BM + bj * HALF + wc * 32 + fq * 8;
                    const u32x4 rb = *(const u32x4*)(E.res + (size_t)row * 1024 + col);
                    const f32x4 x0 = (f32x4){bflo(rb.x), bfhi(rb.x), bflo(rb.y), bfhi(rb.y)} + acc[ai][bj][m][0];
                    const f32x4 x1 = (f32x4){bflo(rb.z), bfhi(rb.z), bflo(rb.w), bfhi(rb.w)} + acc[ai][bj][m][1]; ss += dot4(x0) + dot4(x1);
                    const u32x2 lo = pack4(x0), hi = pack4(x1);
                    *(u32x4*)(E.ob + (size_t)row * 1024 + col) = (u32x4){lo.x, lo.y, hi.x, hi.y}; }
                ss = quad_sum(ss); if (fq == 0) E.stOut[(size_t)row * 16 + u.pn * 4 + wc] = ss;
            }
        }
        asm volatile("" ::: "memory");
    }
}


__device__ __forceinline__ void epi_final(f32x4 (&acc)[2][2][4][2], const Unit& u, int wr, int wc, int fr, int fq, const EpiArgs& E, LAS float* rt) {
    const int tid = threadIdx.x, lane = tid & 63, wid = __builtin_amdgcn_readfirstlane(tid >> 6);
    const int rowb = u.pm * BM + wr * 64 + fr;
#pragma unroll
    for (int ai = 0; ai < 2; ++ai) {
#pragma unroll
        for (int m = 0; m < 4; ++m) {
            const int row = rowb + ai * HALF + m * 16; float ss = 0.f;
#pragma unroll
            for (int bj = 0; bj < 2; ++bj) { const int col = u.pn * BM + bj * HALF + wc * 32 + fq * 8;
                const u32x4 rb = *(const u32x4*)(E.res + (size_t)row * 1024 + col);
                acc[ai][bj][m][0] += (f32x4){bflo(rb.x), bfhi(rb.x), bflo(rb.y), bfhi(rb.y)};
                acc[ai][bj][m][1] += (f32x4){bflo(rb.z), bfhi(rb.z), bflo(rb.w), bfhi(rb.w)};
                ss += dot4(acc[ai][bj][m][0]) + dot4(acc[ai][bj][m][1]); }
            ss = quad_sum(ss);
            if (fq == 0) __hip_atomic_store((unsigned*)E.stOut + (size_t)row * 16 + u.pn * 4 + wc, __float_as_uint(ss), __ATOMIC_RELAXED, __HIP_MEMORY_SCOPE_AGENT);
        }
        asm volatile("" ::: "memory");
    }
    asm volatile("s_waitcnt vmcnt(0)" ::: "memory");
    unsigned* cw = E.cnt + 64 * u.pm;
    if (lane == 0) __hip_atomic_fetch_add(cw, 1u, __ATOMIC_RELAXED, __HIP_MEMORY_SCOPE_AGENT);
    if (E.scnt && blockIdx.x * 8 < MS) {
        if (wid == 0) { unsigned sp = 0;
            while ((unsigned)__builtin_amdgcn_readfirstlane(__hip_atomic_load(E.scnt, __ATOMIC_RELAXED, __HIP_MEMORY_SCOPE_AGENT)) < 8u * 128u) { __builtin_amdgcn_s_sleep(2); if (++sp > (1u << 20)) break; } }
        __syncthreads();
        const int srow = MP + blockIdx.x * 8 + wid;
        float s = __uint_as_float(__hip_atomic_load((const unsigned*)E.stOut + (size_t)srow * 16 + (lane & 15), __ATOMIC_RELAXED, __HIP_MEMORY_SCOPE_AGENT));
        s += __shfl_xor(s, 1); s += __shfl_xor(s, 2); s += __shfl_xor(s, 4); s += __shfl_xor(s, 8);
        const float sr = rsqrtf(s * (1.0f / 1024.0f) + EPS);
        const unsigned long long* sxb = (const unsigned long long*)(E.res + (size_t)srow * 1024);
#pragma unroll
        for (int i = 0; i < 4; ++i) { const int c = i * 256 + lane * 4; const unsigned long long q = __hip_atomic_load(sxb + (c >> 2), __ATOMIC_RELAXED, __HIP_MEMORY_SCOPE_AGENT);
            const unsigned qx = (unsigned)q, qy = (unsigned)(q >> 32); const f32x4 v = {bflo(qx), bfhi(qx), bflo(qy), bfhi(qy)};
            const f32x4 gg = *(const f32x4*)(E.gfin + c); *(f32x4*)(E.yout + (size_t)srow * 1024 + c) = v * sr * gg; }
    }
    if (wid == 0) {
        unsigned sp = 0;
        while ((unsigned)__builtin_amdgcn_readfirstlane(__hip_atomic_load(cw, __ATOMIC_RELAXED, __HIP_MEMORY_SCOPE_AGENT)) < 32u) { __builtin_amdgcn_s_sleep(2); if (++sp > (1u << 20)) break; }
    }
    __syncthreads();
    if (tid < 256) { const unsigned* sp = (const unsigned*)E.stOut + (size_t)(u.pm * BM + tid) * 16; float s = 0.f;
#pragma unroll
        for (int j = 0; j < 16; ++j) s += __uint_as_float(__hip_atomic_load(sp + j, __ATOMIC_RELAXED, __HIP_MEMORY_SCOPE_AGENT));
        rt[tid] = rsqrtf(s * (1.0f / 1024.0f) + EPS); }
    __syncthreads();
#pragma unroll
    for (int ai = 0; ai < 2; ++ai)
#pragma unroll
        for (int m = 0; m < 4; ++m) { const int row = rowb + ai * HALF + m * 16; const float r = rt[ai * HALF + wr * 64 + m * 16 + fr];
#pragma unroll
            for (int bj = 0; bj < 2; ++bj) { const int col = u.pn * BM + bj * HALF + wc * 32 + fq * 8;
                const f32x4 g0 = *(const f32x4*)(E.gfin + col), g1 = *(const f32x4*)(E.gfin + col + 4);
                __builtin_nontemporal_store(acc[ai][bj][m][0] * r * g0, (f32x4*)(E.yout + (size_t)row * 1024 + col));
                __builtin_nontemporal_store(acc[ai][bj][m][1] * r * g1, (f32x4*)(E.yout + (size_t)row * 1024 + col + 4)); } }
}

template <int EK>
__device__ __forceinline__ void skinny_phase(LAS unsigned char* redbase, LAS float* sred, const bf16_t* A, const bf16_t* Bt, int N, int K, const EpiArgs& E);

template <int EK, int SK = -1>
__device__ __forceinline__ void gemm_phase(LAS unsigned char* lds, const bf16_t* A, const bf16_t* Bt, int nM, int N, int K, const EpiArgs& E) {
    const int tid = threadIdx.x, wid = __builtin_amdgcn_readfirstlane(tid >> 6), lane = tid & 63, wr = wid >> 2, wc = wid & 3, fr = lane & 15, fq = lane >> 4;
    const int nt = K / BK;
    SOrder S; S.init(nM, N, (int)gridDim.x, (int)blockIdx.x);
    LAS float* rtab = (LAS float*)(lds + RTAB_OFF);
    unsigned voffA[2], voffB[2];
#pragma unroll
    for (int i = 0; i < 2; ++i) { int R, C; stage_rc(tid * 16 + i * 8192, R, C); const int Rb = (R & ~31) + perm32(R & 31);
        voffA[i] = (unsigned)(R * K + C) * 2u; voffB[i] = (unsigned)(Rb * K + C) * 2u; }
    const size_t kstep = (size_t)(BK * 2);
    const size_t hstep = (size_t)HALF * K * 2;
    const size_t tstep = 2 * hstep;
    const unsigned ldsw = (unsigned)wid * 1024u;
    const int aoff = lds_byte(wr * 64 + fr, fq * 8), boff = lds_byte(wc * 32 + fr, fq * 8);
#define PG8_SA(b, h) (((b) * 2 + (h)) * HTB)
#define PG8_SB(b, h) ((4 + (b) * 2 + (h)) * HTB)
#define PG8_STAGE_(bufoff, gbase, voff) do { _Pragma("unroll") for (int _i = 0; _i < 2; ++_i) \
        __builtin_amdgcn_global_load_lds((const unsigned*)((const char*)(gbase) + voff[_i]), (LAS unsigned*)(lds + (bufoff) + ldsw + _i * 8192), 16, 0, 0); } while (0)
#define PG8_STAGEA(bufoff, gbase) PG8_STAGE_(bufoff, gbase, voffA)
#define PG8_STAGEB(bufoff, gbase) PG8_STAGE_(bufoff, gbase, voffB)
#define PG8_LDA(dst, b, h) do { _Pragma("unroll") for (int m = 0; m < 4; ++m) _Pragma("unroll") for (int k = 0; k < 2; ++k) dst[m][k] = *(const LAS bf16x8*)(lds + PG8_SA(b, h) + aoff + m * 2048 + k * 1024); } while (0)
#define PG8_LDB(dst, b, h) do { _Pragma("unroll") for (int n = 0; n < 2; ++n) _Pragma("unroll") for (int k = 0; k < 2; ++k) dst[n][k] = *(const LAS bf16x8*)(lds + PG8_SB(b, h) + boff + n * 2048 + k * 1024); } while (0)
#define PG8_MMA(ai, bj, At, Bt_) do { __builtin_amdgcn_s_setprio(1); _Pragma("unroll") for (int m = 0; m < 4; ++m) _Pragma("unroll") for (int n = 0; n < 2; ++n) _Pragma("unroll") for (int k = 0; k < 2; ++k) \
        acc[ai][bj][m][n] = __builtin_amdgcn_mfma_f32_16x16x32_bf16(Bt_[n][k], At[m][k], acc[ai][bj][m][n], 0, 0, 0); __builtin_amdgcn_s_setprio(0); } while (0)
#define PG8_WAIT_V(n) asm volatile("s_waitcnt vmcnt(" #n ")" ::: "memory")
#define PG8_WAIT_L(n) asm volatile("s_waitcnt lgkmcnt(" #n ")" ::: "memory")
#define PG8_BAR __builtin_amdgcn_s_barrier()
#define PG8_SCHED __builtin_amdgcn_sched_barrier(0)
    Unit cur, nxt; int ui = 0;
    if (!S.next(0, cur)) { if (SK >= 0) skinny_phase<(SK >= 0 ? SK : 0)>(lds + 32768, (LAS float*)(lds + SRED_OFF), A, Bt, N, K, E); return; }
    f32x4 acc[2][2][4][2];
#pragma unroll
    for (int a = 0; a < 2; ++a)
#pragma unroll
        for (int b = 0; b < 2; ++b)
#pragma unroll
            for (int m = 0; m < 4; ++m)
#pragma unroll
                for (int n = 0; n < 2; ++n) acc[a][b][m][n] = (f32x4){0.f, 0.f, 0.f, 0.f};
    bf16x8 At[4][2], B0[2][2], B1[2][2];
    const char* cA = (const char*)A + (size_t)cur.pm * tstep; const char* cB = (const char*)Bt + (size_t)cur.pn * tstep;
    PG8_STAGEB(PG8_SB(0, 0), cB); PG8_STAGEB(PG8_SB(0, 1), cB + hstep); PG8_STAGEA(PG8_SA(0, 0), cA); PG8_STAGEA(PG8_SA(0, 1), cA + hstep);
    f32x4 tq[4][4]; bool okq[4];
    if (EK != EK_RES && EK != EK_FINAL) {
#pragma unroll
        for (int j = 0; j < 4; ++j) { Unit uu; okq[j] = S.next((tid >> 8) + 2 * j, uu);
            if (okq[j]) { const f32x4* sp = (const f32x4*)(E.stIn + (size_t)(uu.pm * BM + (tid & 255)) * 16); tq[j][0] = sp[0]; tq[j][1] = sp[1]; tq[j][2] = sp[2]; tq[j][3] = sp[3]; } }
    }
    if (SK >= 0) skinny_phase<(SK >= 0 ? SK : 0)>(lds + 32768, (LAS float*)(lds + SRED_OFF), A, Bt, N, K, E);
    if (EK != EK_RES && EK != EK_FINAL) {
#pragma unroll
        for (int j = 0; j < 4; ++j) if (okq[j]) { const float s_ = (hsum4(tq[j][0]) + hsum4(tq[j][1])) + (hsum4(tq[j][2]) + hsum4(tq[j][3]));
            rtab[((tid >> 8) + 2 * j) * 256 + (tid & 255)] = rsqrtf(s_ * (1.0f / 1024.0f) + EPS); }
        __syncthreads();
    }
    if (wr == 1) PG8_BAR;
    PG8_WAIT_V(2); PG8_BAR;
    PG8_STAGEB(PG8_SB(1, 0), cB + kstep); PG8_STAGEA(PG8_SA(1, 0), cA + kstep); PG8_STAGEB(PG8_SB(1, 1), cB + hstep + kstep);
    PG8_WAIT_V(6); PG8_BAR;
    for (;;) {
        const bool has_next = S.next(ui + 1, nxt);
        const char* nA = has_next ? (const char*)A + (size_t)nxt.pm * tstep : cA; const char* nB = has_next ? (const char*)Bt + (size_t)nxt.pn * tstep : cB;
        for (int t = 0; t < nt; t += 2) {
            const bool last = (t == nt - 2);
            const char* a1 = cA + (size_t)(t + 1) * kstep;
            const char* a2 = last ? nA : cA + (size_t)(t + 2) * kstep; const char* b2 = last ? nB : cB + (size_t)(t + 2) * kstep;
            const char* a3 = a2 + kstep; const char* b3 = b2 + kstep;
            PG8_LDB(B0, 0, 0); PG8_LDB(B1, 0, 1); PG8_SCHED; PG8_LDA(At, 0, 0); PG8_STAGEA(PG8_SA(1, 1), a1 + hstep);
            PG8_WAIT_V(8); PG8_WAIT_L(0); PG8_BAR; PG8_MMA(0, 0, At, B0); PG8_MMA(0, 1, At, B1); PG8_BAR; PG8_SCHED;
            PG8_LDA(At, 0, 1); PG8_STAGEB(PG8_SB(0, 0), b2); PG8_STAGEB(PG8_SB(0, 1), b2 + hstep); PG8_STAGEA(PG8_SA(0, 0), a2);
            PG8_WAIT_V(8); PG8_WAIT_L(0); PG8_BAR; PG8_MMA(1, 0, At, B0); PG8_MMA(1, 1, At, B1); PG8_BAR; PG8_SCHED;
            PG8_LDB(B0, 1, 0); PG8_LDB(B1, 1, 1); PG8_SCHED; PG8_LDA(At, 1, 0); PG8_STAGEA(PG8_SA(0, 1), a2 + hstep);
            PG8_WAIT_V(8); PG8_WAIT_L(0); PG8_BAR; PG8_MMA(0, 0, At, B0); PG8_MMA(0, 1, At, B1); PG8_BAR; PG8_SCHED;
            PG8_LDA(At, 1, 1); PG8_STAGEB(PG8_SB(1, 0), b3); PG8_STAGEB(PG8_SB(1, 1), b3 + hstep); PG8_STAGEA(PG8_SA(1, 0), a3);
            PG8_WAIT_V(8); PG8_WAIT_L(0); PG8_BAR; PG8_MMA(1, 0, At, B0); PG8_MMA(1, 1, At, B1); PG8_BAR; PG8_SCHED;
        }
        if (wr == 0) PG8_BAR;
        if (EK == EK_FINAL) epi_final(acc, cur, wr, wc, fr, fq, E, rtab);
        else epi_tile<EK>(acc, cur, wr, wc, fr, fq, E, rtab + ui * 256);
        if (!has_next) break;
#pragma unroll
        for (int a = 0; a < 2; ++a)
#pragma unroll
            for (int b = 0; b < 2; ++b)
#pragma unroll
                for (int m = 0; m < 4; ++m)
#pragma unroll
                    for (int n = 0; n < 2; ++n) acc[a][b][m][n] = (f32x4){0.f, 0.f, 0.f, 0.f};
        cur = nxt; cA = nA; cB = nB; ++ui;
        if (wr == 1) PG8_BAR;
    }
    PG8_WAIT_V(0);
    PG8_BAR;
#undef PG8_SA
#undef PG8_SB
#undef PG8_STAGE_
#undef PG8_STAGEA
#undef PG8_STAGEB
#undef PG8_LDA
#undef PG8_LDB
#undef PG8_MMA
#undef PG8_WAIT_V
#undef PG8_WAIT_L
#undef PG8_BAR
#undef PG8_SCHED
}

template <int EK>
__device__ __forceinline__ void skinny_phase(LAS unsigned char* redbase, LAS float* sred, const bf16_t* A, const bf16_t* Bt, int N, int K, const EpiArgs& E) {
    const int tid = threadIdx.x, wid = __builtin_amdgcn_readfirstlane(tid >> 6), lane = tid & 63, fr = lane & 15, fq = lane >> 4;
    LAS f32x4* red = (LAS f32x4*)redbase;
    const int ncg = (EK == EK_SWIGLU) ? (N / 64) : (N / 64);
    const int nbu = 8 * ncg;
    const int kw = K / 8, k0 = wid * kw;
    for (int bu = blockIdx.x; bu < nbu; bu += gridDim.x) {
        const int rg = bu & 7, cgp = bu >> 3;
        const int row = MP + rg * 16 + fr;
        int br0, br1, br2, br3;
        if (EK == EK_SWIGLU) { const int hc = cgp * 32; const int base = (hc >> 7) * 256 + (hc & 127); br0 = base; br1 = base + 16; br2 = base + 128; br3 = base + 144; }
        else { br0 = cgp * 64; br1 = br0 + 16; br2 = br0 + 32; br3 = br0 + 48; }
        const bf16_t* ap = A + (size_t)row * K + k0 + fq * 8;
        const bf16_t* bp0 = Bt + (size_t)(br0 + fr) * K + k0 + fq * 8;
        const bf16_t* bp1 = Bt + (size_t)(br1 + fr) * K + k0 + fq * 8;
        const bf16_t* bp2 = Bt + (size_t)(br2 + fr) * K + k0 + fq * 8;
        const bf16_t* bp3 = Bt + (size_t)(br3 + fr) * K + k0 + fq * 8;
        f32x4 a0 = {0.f, 0.f, 0.f, 0.f}, a1 = a0, a2 = a0, a3 = a0;
        f32x4 stq = {0.f, 0.f, 0.f, 0.f};
        if (EK != EK_RES && wid < 4) stq = *(const f32x4*)(E.stIn + (size_t)row * 16 + fq * 4);
        u32x2 rpre = {0u, 0u};
        if (EK == EK_RES && wid < 4) rpre = *(const u32x2*)(E.res + (size_t)row * 1024 + cgp * 64 + wid * 16 + fq * 4);
#pragma unroll 4
        for (int k = 0; k < kw; k += 32) {
            const bf16x8 a = *(const bf16x8*)(ap + k);
            const bf16x8 b0 = *(const bf16x8*)(bp0 + k), b1 = *(const bf16x8*)(bp1 + k), b2 = *(const bf16x8*)(bp2 + k), b3 = *(const bf16x8*)(bp3 + k);
            a0 = __builtin_amdgcn_mfma_f32_16x16x32_bf16(b0, a, a0, 0, 0, 0);
            a1 = __builtin_amdgcn_mfma_f32_16x16x32_bf16(b1, a, a1, 0, 0, 0);
            a2 = __builtin_amdgcn_mfma_f32_16x16x32_bf16(b2, a, a2, 0, 0, 0);
            a3 = __builtin_amdgcn_mfma_f32_16x16x32_bf16(b3, a, a3, 0, 0, 0);
        }
        red[(wid * 4 + 0) * 64 + lane] = a0; red[(wid * 4 + 1) * 64 + lane] = a1; red[(wid * 4 + 2) * 64 + lane] = a2; red[(wid * 4 + 3) * 64 + lane] = a3;
        __syncthreads();
        float ss = 0.f;
        if (wid < 4) {
            float r = 1.f;
            if (EK != EK_RES) { const float s = quad_sum(hsum4(stq)); r = rsqrtf(s * (1.0f / 1024.0f) + EPS); }
            if (EK == EK_SWIGLU) {
                if (wid < 2) {
                    f32x4 g = red[wid * 64 + lane], uu = red[(wid + 2) * 64 + lane];
#pragma unroll
                    for (int ww = 1; ww < 8; ++ww) { g += red[(ww * 4 + wid) * 64 + lane]; uu += red[(ww * 4 + wid + 2) * 64 + lane]; }
                    const int col = cgp * 32 + wid * 16 + fq * 4;
                    *(u32x2*)(E.ob + (size_t)row * DFF + col) = pack4(swiglu4(g * r, uu * r));
                }
            } else {
                f32x4 v = red[wid * 64 + lane];
#pragma unroll
                for (int ww = 1; ww < 8; ++ww) v += red[(ww * 4 + wid) * 64 + lane];
                const int col = cgp * 64 + wid * 16 + fq * 4;
                if (EK == EK_SCALE) { *(u32x2*)(E.ob + (size_t)row * E.ldb + col) = pack4(v * r); }
                else if (EK == EK_GELU) { const f32x4 z = gelu4(v * r); ss = dot4(z); *(u32x2*)(E.ob + (size_t)row * E.ldb + col) = pack4(z); }
                else { const u32x2 rb = rpre;
                    const f32x4 x = (f32x4){bflo(rb.x), bfhi(rb.x), bflo(rb.y), bfhi(rb.y)} + v; ss = dot4(x);
                    const u32x2 pk = pack4(x);
                    if (E.scnt) __hip_atomic_store((unsigned long long*)(E.ob + (size_t)row * 1024 + col), ((unsigned long long)pk.y << 32) | pk.x, __ATOMIC_RELAXED, __HIP_MEMORY_SCOPE_AGENT);
                    else *(u32x2*)(E.ob + (size_t)row * 1024 + col) = pk; }
            }
            if (EK == EK_RES || EK == EK_GELU) { ss = quad_sum(ss); if (fq == 0) sred[wid * 16 + fr] = ss; }
        }
        __syncthreads();
        if (EK == EK_RES || EK == EK_GELU) {
            if (tid < 16) { const float tot = (sred[tid] + sred[16 + tid]) + (sred[32 + tid] + sred[48 + tid]);
                if (EK == EK_RES) { if (E.scnt) __hip_atomic_store((unsigned*)E.stOut + (size_t)(MP + rg * 16 + tid) * 16 + cgp, __float_as_uint(tot), __ATOMIC_RELAXED, __HIP_MEMORY_SCOPE_AGENT);
                    else E.stOut[(size_t)(MP + rg * 16 + tid) * 16 + cgp] = tot; }
                else if (cgp >= 16) E.stOut[(size_t)(MP + rg * 16 + tid) * 16 + (cgp - 16)] = tot; }
            __syncthreads();
        }
        if (EK == EK_RES && E.scnt) {
            asm volatile("s_waitcnt vmcnt(0)" ::: "memory");
            if (lane == 0) __hip_atomic_fetch_add(E.scnt, 1u, __ATOMIC_RELAXED, __HIP_MEMORY_SCOPE_AGENT);
        }
    }
}

constexpr int NT_L0 = 724, NT_ALL = 1444, NT_WS = 32;
#define WJOB_DECODE(t_, src, dst, gain, K, N, k0, n0, drow0) do { \
        const int L_ = (t_) >= NT_L0; int tt_ = L_ ? (t_) - NT_L0 : (t_); int mode_ = 0; gain = nullptr; \
        if (tt_ < 128)      { src = L_ ? p.in[12] : p.in[7]; dst = (bf16_t*)(p.ws + (L_ ? OFF_W_INO : OFF_W_INE)); gain = p.in[4] + L_ * 1024; K = 1024; N = 2048; } \
        else if (tt_ < 192) { tt_ -= 128; src = L_ ? p.in[16] : p.in[11]; dst = (bf16_t*)(p.ws + (L_ ? OFF_W_OUTO : OFF_W_OUTE)); K = 1024; N = 1024; } \
        else if (tt_ < 368) { tt_ -= 192; src = p.in[17] + (size_t)L_ * 1024 * DFF; dst = (bf16_t*)(p.ws + (L_ ? OFF_W_GU1 : OFF_W_GU0)); gain = p.in[5] + L_ * 1024; K = 1024; N = DFF; mode_ = 1; } \
        else if (tt_ < 544) { tt_ -= 368; src = p.in[18] + (size_t)L_ * 1024 * DFF; dst = (bf16_t*)(p.ws + (L_ ? OFF_W_GU1 : OFF_W_GU0)); gain = p.in[5] + L_ * 1024; K = 1024; N = DFF; mode_ = 2; } \
        else if (tt_ < 720) { tt_ -= 544; src = p.in[19] + (size_t)L_ * DFF * 1024; dst = (bf16_t*)(p.ws + (L_ ? OFF_W_DN1 : OFF_W_DN0)); K = DFF; N = 1024; } \
        else { const int g_ = tt_ - 720; src = p.in[8] + (size_t)g_ * 16384; dst = (bf16_t*)(p.ws + OFF_W_POOL) + (size_t)g_ * 16384; K = 128; N = 128; tt_ = 0; } \
        const int ntn_ = N >> 7; k0 = (tt_ / ntn_) * 128; n0 = (tt_ % ntn_) * 128; \
        drow0 = mode_ ? ((n0 >> 7) * 256 + (mode_ == 2 ? 128 : 0)) : n0; } while (0)
__device__ __forceinline__ void prep_tiles(const Params& p, LAS unsigned char* lds, int t_first, int t_end, int stride) {
    const int tid = threadIdx.x;
    LAS float* tl = (LAS float*)lds;
    f32x4 pf[8];
    if (t_first < t_end) { const float* src; bf16_t* dst; const float* gain; int K, N, k0, n0, drow0; WJOB_DECODE(t_first, src, dst, gain, K, N, k0, n0, drow0);
        (void)dst; (void)gain; (void)K; (void)drow0;
#pragma unroll
        for (int i = 0; i < 8; ++i) { const int e = tid + 512 * i; pf[i] = ldnt((const f32x4*)(src + (size_t)(k0 + (e >> 5)) * N + n0 + (e & 31) * 4)); } }
    for (int t = t_first; t < t_end; t += stride) {
        f32x4 cf[8];
#pragma unroll
        for (int i = 0; i < 8; ++i) cf[i] = pf[i];
        if (t + stride < t_end) { const float* src; bf16_t* dst; const float* gain; int K, N, k0, n0, drow0; WJOB_DECODE(t + stride, src, dst, gain, K, N, k0, n0, drow0);
            (void)dst; (void)gain; (void)K; (void)drow0;
#pragma unroll
            for (int i = 0; i < 8; ++i) { const int e = tid + 512 * i; pf[i] = ldnt((const f32x4*)(src + (size_t)(k0 + (e >> 5)) * N + n0 + (e & 31) * 4)); } }
#pragma unroll
        for (int i = 0; i < 8; ++i) { const int e = tid + 512 * i, kk = e >> 5, n4 = (e & 31) * 4;
            tl[kk * 129 + n4 + 0] = cf[i][0]; tl[kk * 129 + n4 + 1] = cf[i][1]; tl[kk * 129 + n4 + 2] = cf[i][2]; tl[kk * 129 + n4 + 3] = cf[i][3]; }
        LDS_BARRIER();
        { const float* src; bf16_t* dst; const float* gain; int K, N, k0, n0, drow0; WJOB_DECODE(t, src, dst, gain, K, N, k0, n0, drow0); (void)src; (void)N; (void)n0;
            const int nn = tid >> 2, a8 = (tid & 3) * 8;
#pragma unroll
            for (int q = 0; q < 4; ++q) { const int kb = a8 + 32 * q; float v[8];
#pragma unroll
                for (int j = 0; j < 8; ++j) v[j] = tl[(kb + j) * 129 + nn];
                if (gain) { const f32x4 g0 = *(const f32x4*)(gain + k0 + kb), g1 = *(const f32x4*)(gain + k0 + kb + 4);
                    v[0] *= g0[0]; v[1] *= g0[1]; v[2] *= g0[2]; v[3] *= g0[3]; v[4] *= g1[0]; v[5] *= g1[1]; v[6] *= g1[2]; v[7] *= g1[3]; }
                u32x4 w; w.x = cvt_pk_bf16(v[0], v[1]); w.y = cvt_pk_bf16(v[2], v[3]); w.z = cvt_pk_bf16(v[4], v[5]); w.w = cvt_pk_bf16(v[6], v[7]);
                *(u32x4*)(dst + (size_t)(drow0 + nn) * K + k0 + kb) = w; } }
        LDS_BARRIER();
    }
}
__device__ __forceinline__ void prep_ws(const Params& p, int u_first, int stride) {
    const int tid = threadIdx.x;
    for (int u = u_first; u < NT_WS; u += stride) {
        const int base = u * 4096 + tid * 8;
        const int s0 = base & 127, tq = (base >> 7) & 127;
        const f32x4 v0 = *(const f32x4*)(p.in[14] + base), v1 = *(const f32x4*)(p.in[14] + base + 4);
        float v[8] = {v0[0], v0[1], v0[2], v0[3], v1[0], v1[1], v1[2], v1[3]};
#pragma unroll
        for (int j = 0; j < 8; ++j) if (s0 + j > tq) v[j] = 0.f;
        u32x4 w; w.x = cvt_pk_bf16(v[0], v[1]); w.y = cvt_pk_bf16(v[2], v[3]); w.z = cvt_pk_bf16(v[4], v[5]); w.w = cvt_pk_bf16(v[6], v[7]);
        *(u32x4*)((bf16_t*)(p.ws + OFF_W_WS) + base) = w;
    }
}
__device__ __forceinline__ void prep_phase(const Params& p, LAS unsigned char* lds) {
    const int tid = threadIdx.x, lane = tid & 63, wid = tid >> 6;
    {
        const int gw = blockIdx.x * 8 + wid, nw = gridDim.x * 8;
        f32x4 xv[4];
        if (gw < MTOT) { const float* xs = gw < MP ? p.in[0] + (size_t)gw * 1024 : p.in[1] + (size_t)(gw - MP) * 1024;
#pragma unroll
            for (int i = 0; i < 4; ++i) xv[i] = ldnt((const f32x4*)(xs + i * 256 + lane * 4)); }
        for (int row = gw; row < MTOT; row += nw) {
            f32x4 cv[4];
#pragma unroll
            for (int i = 0; i < 4; ++i) cv[i] = xv[i];
            const int nr = row + nw;
            if (nr < MTOT) { const float* xs = nr < MP ? p.in[0] + (size_t)nr * 1024 : p.in[1] + (size_t)(nr - MP) * 1024;
#pragma unroll
                for (int i = 0; i < 4; ++i) xv[i] = ldnt((const f32x4*)(xs + i * 256 + lane * 4)); }
            bf16_t* xb = (bf16_t*)(p.ws + OFF_XB) + (size_t)row * 1024;
            float ss = 0.f;
#pragma unroll
            for (int i = 0; i < 4; ++i) { ss += dot4(cv[i]); *(u32x2*)(xb + i * 256 + lane * 4) = pack4(cv[i]); }
            ss = wave_sum(ss);
            if (lane < 16) ((float*)(p.ws + OFF_ST))[(size_t)row * 16 + lane] = lane == 0 ? ss : 0.f;
        }
    }
    prep_tiles(p, lds, blockIdx.x, NT_L0, gridDim.x);
}

constexpr int DM_OFF = 79 * 128 * 4;
#define CONV_F(dst, x, c) do { dst[0] = bflo(x.x) * bflo(c.x); dst[1] = bfhi(x.x) * bfhi(c.x); dst[2] = bflo(x.y) * bflo(c.y); dst[3] = bfhi(x.y) * bfhi(c.y); \
    dst[4] = bflo(x.z) * bflo(c.z); dst[5] = bfhi(x.z) * bfhi(c.z); dst[6] = bflo(x.w) * bflo(c.w); dst[7] = bfhi(x.w) * bfhi(c.w); } while (0)
__device__ __forceinline__ void mixer_phase(const Params& p, LAS unsigned char* lds) {
    const int tid = threadIdx.x, wid = __builtin_amdgcn_readfirstlane(tid >> 6), lane = tid & 63, fr = lane & 15, fq = lane >> 4;
    const int bx = blockIdx.x, G = gridDim.x;
    const bf16_t* zb = (const bf16_t*)(p.ws + OFF_ZB);
    bf16_t* mix = (bf16_t*)(p.ws + OFF_MIXB);
    LAS float* P = (LAS float*)lds;
    LAS bf16_t* Dm = (LAS bf16_t*)(lds + DM_OFF);
    const int mt = wid & 3, nh = wid >> 2;
    int gcur = -1; bf16x8 wb[4][4]; f32x4 scv[4];
#define POOL_LOADW(g_) do { if ((g_) != gcur) { gcur = (g_); const bf16_t* wp = (const bf16_t*)(p.ws + OFF_W_POOL) + (size_t)gcur * 16384; \
        _Pragma("unroll") for (int ks = 0; ks < 4; ++ks) _Pragma("unroll") for (int nt = 0; nt < 4; ++nt) wb[ks][nt] = *(const bf16x8*)(wp + (size_t)(nh * 64 + (nt >> 1) * 32 + 8 * (fr >> 2) + 4 * (nt & 1) + (fr & 3)) * 128 + ks * 32 + fq * 8); \
        _Pragma("unroll") for (int nt = 0; nt < 4; ++nt) scv[nt] = *(const f32x4*)(p.in[9] + gcur * 128 + nh * 64 + (nt >> 1) * 32 + fq * 8 + (nt & 1) * 4); } } while (0)
#define POOL_MMA_STORE(g_, growbase) do { f32x4 acc[4]; _Pragma("unroll") for (int j = 0; j < 4; ++j) acc[j] = (f32x4){0.f, 0.f, 0.f, 0.f}; \
        _Pragma("unroll") for (int ks = 0; ks < 4; ++ks) { const bf16x8 a = *(const LAS bf16x8*)(Dm + (mt * 16 + fr) * 136 + ks * 32 + fq * 8); \
            _Pragma("unroll") for (int nt = 0; nt < 4; ++nt) acc[nt] = __builtin_amdgcn_mfma_f32_16x16x32_bf16(wb[ks][nt], a, acc[nt], 0, 0, 0); } \
        _Pragma("unroll") for (int k2 = 0; k2 < 2; ++k2) { const u32x2 lo_ = pack4(acc[2 * k2] * scv[2 * k2]), hi_ = pack4(acc[2 * k2 + 1] * scv[2 * k2 + 1]); \
            *(u32x4*)(mix + (size_t)((growbase) + mt * 16 + fr) * 1024 + (g_) * 128 + nh * 64 + k2 * 32 + fq * 8) = (u32x4){lo_.x, lo_.y, hi_.x, hi_.y}; } } while (0)
    u32x4 pq[3];
#define POOL_PREFETCH(uu) do { const int tt_ = (uu) >> 2, g_ = (uu) & 3, b_ = tt_ >> 5, t0_ = (tt_ & 31) * 64; \
        _Pragma("unroll") for (int i = 0; i < 3; ++i) { const int o = tid + 512 * i, rr = o >> 4, c8 = (o & 15) * 8, tpos = t0_ - 15 + rr; \
            pq[i] = (u32x4){0u, 0u, 0u, 0u}; if (o < 79 * 16 && tpos >= 0) pq[i] = ldnt((const u32x4*)(zb + (size_t)(b_ * T + tpos) * 2048 + g_ * 128 + c8)); } } while (0)
    if (bx < 1024) POOL_PREFETCH(bx);
    for (int tt = bx; tt < 256; tt += G) {
        const int b = tt >> 5, t0 = (tt & 31) * 64;
        const int c8 = (tid & 63) * 8, ts = t0 + (tid >> 6) * 8;
        float w0[8], w1[8], w2[8], f1[8], f2[8];
        { const float* cw = p.in[10] + c8;
            const f32x4 a0 = *(const f32x4*)(cw), a1 = *(const f32x4*)(cw + 4), b0 = *(const f32x4*)(cw + 512), b1 = *(const f32x4*)(cw + 516), c0 = *(const f32x4*)(cw + 1024), c1 = *(const f32x4*)(cw + 1028);
#pragma unroll
            for (int j = 0; j < 4; ++j) { w0[j] = a0[j]; w0[j + 4] = a1[j]; w1[j] = b0[j]; w1[j + 4] = b1[j]; w2[j] = c0[j]; w2[j + 4] = c1[j]; } }
#pragma unroll
        for (int j = 0; j < 8; ++j) { f1[j] = 0.f; f2[j] = 0.f; }
        if (ts >= 2) { const bf16_t* zr = zb + (size_t)(b * T + ts - 2) * 2048; const u32x4 x = *(const u32x4*)(zr + 512 + c8), c = *(const u32x4*)(zr + 1536 + c8); CONV_F(f2, x, c); }
        if (ts >= 1) { const bf16_t* zr = zb + (size_t)(b * T + ts - 1) * 2048; const u32x4 x = *(const u32x4*)(zr + 512 + c8), c = *(const u32x4*)(zr + 1536 + c8); CONV_F(f1, x, c); }
#pragma unroll
        for (int i = 0; i < 8; ++i) {
            const int t = ts + i; const bf16_t* zr = zb + (size_t)(b * T + t) * 2048;
            const u32x4 x = ldnt((const u32x4*)(zr + 512 + c8)), bg = ldnt((const u32x4*)(zr + 1024 + c8)), c = ldnt((const u32x4*)(zr + 1536 + c8));
            float f0[8], bgf[8], o[8];
            CONV_F(f0, x, c);
            bgf[0] = bflo(bg.x); bgf[1] = bfhi(bg.x); bgf[2] = bflo(bg.y); bgf[3] = bfhi(bg.y); bgf[4] = bflo(bg.z); bgf[5] = bfhi(bg.z); bgf[6] = bflo(bg.w); bgf[7] = bfhi(bg.w);
#pragma unroll
            for (int j = 0; j < 8; ++j) o[j] = bgf[j] * (f2[j] * w0[j] + f1[j] * w1[j] + f0[j] * w2[j]);
            u32x4 wv; wv.x = cvt_pk_bf16(o[0], o[1]); wv.y = cvt_pk_bf16(o[2], o[3]); wv.z = cvt_pk_bf16(o[4], o[5]); wv.w = cvt_pk_bf16(o[6], o[7]);
            *(u32x4*)(mix + (size_t)(b * T + t) * 1024 + 512 + c8) = wv;
            if (t >= T - 2) { float* so = p.out + OUT_CONVP + (size_t)(b * 2 + (t - (T - 2))) * 512 + c8;
                *(f32x4*)(so) = (f32x4){f0[0], f0[1], f0[2], f0[3]}; *(f32x4*)(so + 4) = (f32x4){f0[4], f0[5], f0[6], f0[7]}; }
#pragma unroll
            for (int j = 0; j < 8; ++j) { f2[j] = f1[j]; f1[j] = f0[j]; }
        }
    }
    for (int u = bx; u < 1024; u += G) {
        const int tt = u >> 2, g = u & 3, b = tt >> 5, t0 = (tt & 31) * 64, grow0 = b * T + t0, w = 2 << g;
        POOL_LOADW(g);
        u32x4 cp[3];
#pragma unroll
        for (int i = 0; i < 3; ++i) cp[i] = pq[i];
        if (u + G < 1024) POOL_PREFETCH(u + G);
#pragma unroll
        for (int i = 0; i < 3; ++i) { const int o = tid + 512 * i, rr = o >> 4, c8 = (o & 15) * 8;
            if (o < 79 * 16) { const u32x4 q = cp[i];
                *(LAS f32x4*)(P + rr * 128 + c8) = (f32x4){bflo(q.x), bfhi(q.x), bflo(q.y), bfhi(q.y)}; *(LAS f32x4*)(P + rr * 128 + c8 + 4) = (f32x4){bflo(q.z), bfhi(q.z), bflo(q.w), bfhi(q.w)}; } }
        LDS_BARRIER();
        { const int c = tid & 127, tl0 = (tid >> 7) * 16; const float invw = 1.0f / (float)w;
            float S = 0.f;
            for (int j = 1; j < w; ++j) S += P[(tl0 + 15 - j) * 128 + c];
#pragma unroll 4
            for (int i = 0; i < 16; ++i) { const int tl = tl0 + i; const float cur = P[(tl + 15) * 128 + c]; S += cur;
                const int pos = t0 + tl; const float inv = (pos + 1 >= w) ? invw : __builtin_amdgcn_rcpf((float)(pos + 1));
                Dm[tl * 136 + c] = f2bf(S * inv - cur);
                S -= P[(tl + 16 - w) * 128 + c]; }
        }
        if (t0 == T - 64) {
            for (int e = tid; e < 15 * 128; e += 512) { const int i = e >> 7, c = e & 127;
                p.out[OUT_POOLP + (size_t)(b * 15 + i) * 512 + g * 128 + c] = P[(64 + i) * 128 + c]; }
        }
        LDS_BARRIER();
        POOL_MMA_STORE(g, grow0);
    }
    for (int us = bx; us < 48; us += G) {
        if (us < 32) {
            const int g = us & 3, rb = us >> 2, w = 2 << g;
            POOL_LOADW(g);
            const int c = tid & 127, q = tid >> 7;
            float hv[4][15], pv[4];
#pragma unroll
            for (int i = 0; i < 4; ++i) { const int bs = rb * 16 + q * 4 + i; const float* hp = p.in[2] + (size_t)bs * 15 * 512 + g * 128 + c;
#pragma unroll
                for (int j = 0; j < 15; ++j) hv[i][j] = hp[j * 512];
                pv[i] = bf2f(zb[(size_t)(MP + bs) * 2048 + g * 128 + c]); }
            __syncthreads();
#pragma unroll
            for (int i = 0; i < 4; ++i) { const int bs = rb * 16 + q * 4 + i; float* so = p.out + OUT_POOLS + (size_t)bs * 15 * 512 + g * 128 + c;
                float S = pv[i];
#pragma unroll
                for (int j = 0; j < 15; ++j) { S += (j >= 16 - w) ? hv[i][j] : 0.f; if (j >= 1) so[(j - 1) * 512] = hv[i][j]; }
                so[14 * 512] = pv[i];
                Dm[(q * 4 + i) * 136 + c] = f2bf(S / (float)w - pv[i]); }
            __syncthreads();
            if (mt == 0) POOL_MMA_STORE(g, MP + rb * 16);
        } else {
            const int c8 = (tid & 63) * 8, bs = (us - 32) * 8 + (tid >> 6);
            const float* cw = p.in[10] + c8;
            f32x4 wq[3][2];
#pragma unroll
            for (int k = 0; k < 3; ++k) { wq[k][0] = *(const f32x4*)(cw + k * 512); wq[k][1] = *(const f32x4*)(cw + k * 512 + 4); }
            const bf16_t* zr = zb + (size_t)(MP + bs) * 2048;
            const u32x4 x = *(const u32x4*)(zr + 512 + c8), bg = *(const u32x4*)(zr + 1024 + c8), c = *(const u32x4*)(zr + 1536 + c8);
            const float* hp = p.in[3] + (size_t)bs * 2 * 512 + c8;
            f32x4 h0[2] = {*(const f32x4*)(hp), *(const f32x4*)(hp + 4)}, h1[2] = {*(const f32x4*)(hp + 512), *(const f32x4*)(hp + 516)};
            f32x4 f0[2], bgf[2];
            f0[0] = (f32x4){bflo(x.x) * bflo(c.x), bfhi(x.x) * bfhi(c.x), bflo(x.y) * bflo(c.y), bfhi(x.y) * bfhi(c.y)};
            f0[1] = (f32x4){bflo(x.z) * bflo(c.z), bfhi(x.z) * bfhi(c.z), bflo(x.w) * bflo(c.w), bfhi(x.w) * bfhi(c.w)};
            bgf[0] = (f32x4){bflo(bg.x), bfhi(bg.x), bflo(bg.y), bfhi(bg.y)}; bgf[1] = (f32x4){bflo(bg.z), bfhi(bg.z), bflo(bg.w), bfhi(bg.w)};
            float* so = p.out + OUT_CONVS + (size_t)bs * 2 * 512 + c8;
            u32x4 wv;
            { const f32x4 o = bgf[0] * (h0[0] * wq[0][0] + h1[0] * wq[1][0] + f0[0] * wq[2][0]); wv.x = cvt_pk_bf16(o[0], o[1]); wv.y = cvt_pk_bf16(o[2], o[3]); }
            { const f32x4 o = bgf[1] * (h0[1] * wq[0][1] + h1[1] * wq[1][1] + f0[1] * wq[2][1]); wv.z = cvt_pk_bf16(o[0], o[1]); wv.w = cvt_pk_bf16(o[2], o[3]); }
            *(u32x4*)(mix + (size_t)(MP + bs) * 1024 + 512 + c8) = wv;
            *(f32x4*)(so) = h1[0]; *(f32x4*)(so + 4) = h1[1]; *(f32x4*)(so + 512) = f0[0]; *(f32x4*)(so + 516) = f0[1];
        }
    }
#undef POOL_LOADW
#undef POOL_MMA_STORE
#undef POOL_PREFETCH
}

__device__ __forceinline__ void gating_phase(const Params& p, LAS unsigned char* lds) {
    const int tid = threadIdx.x, wid = __builtin_amdgcn_readfirstlane(tid >> 6), lane = tid & 63, fr = lane & 15, fq = lane >> 4;
    const int bx = blockIdx.x, G = gridDim.x;
    const bf16_t* zb = (const bf16_t*)(p.ws + OFF_ZB);
    bf16_t* mix = (bf16_t*)(p.ws + OFF_MIXB);
    const float* stv = (const float*)(p.ws + OFF_ST + 3 * ST_BYTES);
    const float* gv = p.in[13];
    LAS bf16_t* vT = (LAS bf16_t*)lds;
    u32x4 vq[4]; float stp[4]; u32x4 un[4];
    const int d8 = (tid & 15) * 8;
#define GATE_PREFETCH(uu_) do { const int h_ = (uu_) & 7, ch_ = ((uu_) >> 3) & 15, b_ = (uu_) >> 7, gr_ = b_ * T + ch_ * 128; \
        _Pragma("unroll") for (int i = 0; i < 4; ++i) { const int s_ = 2 * (tid >> 4) + 64 * (i >> 1) + (i & 1); \
            vq[i] = ldnt((const u32x4*)(zb + (size_t)(gr_ + s_) * 2048 + 1024 + h_ * 128 + d8)); stp[i] = stv[(size_t)(gr_ + s_) * 16 + (tid & 15)]; } \
        _Pragma("unroll") for (int k2 = 0; k2 < 4; ++k2) un[k2] = ldnt((const u32x4*)(zb + (size_t)(gr_ + wid * 16 + fr) * 2048 + h_ * 128 + k2 * 32 + fq * 8)); } while (0)
    if (bx < 1024) GATE_PREFETCH(bx);
    for (int wu = bx * 8 + wid; wu < 512; wu += G * 8) {
        const int bs = wu >> 2, row = MP + bs, c = (wu & 3) * 256 + lane * 4, h = c >> 7;
        float s = stv[(size_t)row * 16 + (lane & 15)];
        s += __shfl_xor(s, 1); s += __shfl_xor(s, 2); s += __shfl_xor(s, 4); s += __shfl_xor(s, 8);
        const float rv = rsqrtf(s * (1.0f / 1024.0f) + EPS);
        const u32x2 vv = *(const u32x2*)(zb + (size_t)row * 2048 + 1024 + c), uu = *(const u32x2*)(zb + (size_t)row * 2048 + c);
        const f32x4 g = *(const f32x4*)(gv + c);
        const f32x4 vn = (f32x4){bflo(vv.x), bfhi(vv.x), bflo(vv.y), bfhi(vv.y)} * rv * g;
        *(f32x4*)(p.out + OUT_SGV + (size_t)bs * 1024 + c) = vn;
        const float w00 = p.in[14][(size_t)h * 16384], b0 = p.in[15][h * 128];
        const f32x4 uf = {bflo(uu.x), bfhi(uu.x), bflo(uu.y), bfhi(uu.y)};
        *(u32x2*)(mix + (size_t)row * 1024 + c) = pack4(uf * (vn * w00 + b0));
    }
    int hcur = -1; bf16x8 af[4]; f32x4 g0, g1; float bias = 0.f;
    for (int u = bx; u < 1024; u += G) {
        const int h = u & 7, ch = (u >> 3) & 15, b = u >> 7, grow0 = b * T + ch * 128;
        if (h != hcur) { hcur = h; const bf16_t* wsb = (const bf16_t*)(p.ws + OFF_W_WS) + (size_t)h * 16384;
#pragma unroll
            for (int ks = 0; ks < 4; ++ks) af[ks] = *(const bf16x8*)(wsb + (size_t)(wid * 16 + fr) * 128 + ks * 32 + fq * 8);
            g0 = *(const f32x4*)(gv + h * 128 + d8); g1 = *(const f32x4*)(gv + h * 128 + d8 + 4); bias = p.in[15][h * 128 + wid * 16 + fr]; }
        u32x4 cq[4]; float cst[4]; u32x4 uc[4];
#pragma unroll
        for (int i = 0; i < 4; ++i) { cq[i] = vq[i]; cst[i] = stp[i]; }
#pragma unroll
        for (int k2 = 0; k2 < 4; ++k2) uc[k2] = un[k2];
        if (u + G < 1024) GATE_PREFETCH(u + G);
#pragma unroll
        for (int ip = 0; ip < 2; ++ip) {
            const int s0 = 2 * (tid >> 4) + 64 * ip;
            float sa = cst[2 * ip], sb = cst[2 * ip + 1];
            sa += __shfl_xor(sa, 1); sa += __shfl_xor(sa, 2); sa += __shfl_xor(sa, 4); sa += __shfl_xor(sa, 8);
            sb += __shfl_xor(sb, 1); sb += __shfl_xor(sb, 2); sb += __shfl_xor(sb, 4); sb += __shfl_xor(sb, 8);
            const float ra = rsqrtf(sa * (1.0f / 1024.0f) + EPS), rb = rsqrtf(sb * (1.0f / 1024.0f) + EPS);
            const u32x4 qa = cq[2 * ip], qb = cq[2 * ip + 1];
            const float va[8] = {bflo(qa.x) * ra * g0[0], bfhi(qa.x) * ra * g0[1], bflo(qa.y) * ra * g0[2], bfhi(qa.y) * ra * g0[3],
                                 bflo(qa.z) * ra * g1[0], bfhi(qa.z) * ra * g1[1], bflo(qa.w) * ra * g1[2], bfhi(qa.w) * ra * g1[3]};
            const float vb[8] = {bflo(qb.x) * rb * g0[0], bfhi(qb.x) * rb * g0[1], bflo(qb.y) * rb * g0[2], bfhi(qb.y) * rb * g0[3],
                                 bflo(qb.z) * rb * g1[0], bfhi(qb.z) * rb * g1[1], bflo(qb.w) * rb * g1[2], bfhi(qb.w) * rb * g1[3]};
#pragma unroll
            for (int j = 0; j < 8; ++j) {
                const int slot = (d8 & ~31) + (j >> 2) * 16 + ((d8 & 31) >> 3) * 4 + (j & 3);
                *(LAS unsigned*)(vT + slot * 136 + (s0 ^ (((slot >> 3) & 15) << 3))) = cvt_pk_bf16(va[j], vb[j]); }
        }
        LDS_BARRIER();
        f32x4 acc[8];
#pragma unroll
        for (int j = 0; j < 8; ++j) acc[j] = (f32x4){0.f, 0.f, 0.f, 0.f};
        const int nks = (wid >> 1) + 1;
#pragma unroll
        for (int ks = 0; ks < 4; ++ks) if (ks < nks) {
#pragma unroll
            for (int nt = 0; nt < 8; ++nt) { const int d = nt * 16 + fr; const int sw = (ks * 32 + fq * 8) ^ (((d >> 3) & 15) << 3);
                const bf16x8 bb = *(const LAS bf16x8*)(vT + d * 136 + sw);
                acc[nt] = __builtin_amdgcn_mfma_f32_16x16x32_bf16(bb, af[ks], acc[nt], 0, 0, 0); }
        }
        { bf16_t* orow = mix + (size_t)(grow0 + wid * 16 + fr) * 1024 + h * 128;
#pragma unroll
            for (int k2 = 0; k2 < 4; ++k2) { const u32x4 uu = uc[k2];
                const f32x4 u0 = {bflo(uu.x), bfhi(uu.x), bflo(uu.y), bfhi(uu.y)}, u1 = {bflo(uu.z), bfhi(uu.z), bflo(uu.w), bfhi(uu.w)};
                const u32x2 lo = pack4(u0 * (acc[2 * k2] + bias)), hi = pack4(u1 * (acc[2 * k2 + 1] + bias));
                *(u32x4*)(orow + k2 * 32 + fq * 8) = (u32x4){lo.x, lo.y, hi.x, hi.y}; } }
        LDS_BARRIER();
    }
#undef GATE_PREFETCH
}

__device__ __forceinline__ void final_phase(const Params& p, int row0) {
    const int tid = threadIdx.x, wid = tid >> 6, lane = tid & 63;
    const float* st = (const float*)(p.ws + OFF_ST + 5 * ST_BYTES);
    const float* g = p.in[6];
    for (int row = row0 + blockIdx.x * 8 + wid; row < MTOT; row += gridDim.x * 8) {
        const f32x4* sp = (const f32x4*)(st + (size_t)row * 16);
        const float s = (hsum4(sp[0]) + hsum4(sp[1])) + (hsum4(sp[2]) + hsum4(sp[3])); const float r = rsqrtf(s * (1.0f / 1024.0f) + EPS);
        float* xr = p.out + (size_t)row * 1024; const bf16_t* xb = (const bf16_t*)(p.ws + OFF_XB) + (size_t)row * 1024;
#pragma unroll
        for (int i = 0; i < 4; ++i) { const int c = i * 256 + lane * 4; const u32x2 q = *(const u32x2*)(xb + c); const f32x4 v = {bflo(q.x), bfhi(q.x), bflo(q.y), bfhi(q.y)};
            const f32x4 gg = *(const f32x4*)(g + c); *(f32x4*)(xr + c) = v * r * gg; }
    }
}

__device__ __forceinline__ void final_sample_fused(const Params& p, unsigned* scnt) {
    if (blockIdx.x * 8 >= MS) return;
    const int tid = threadIdx.x, wid = __builtin_amdgcn_readfirstlane(tid >> 6);
    if (wid == 0) { unsigned sp = 0;
        while ((unsigned)__builtin_amdgcn_readfirstlane(__hip_atomic_load(scnt, __ATOMIC_RELAXED, __HIP_MEMORY_SCOPE_AGENT)) < 8u * 128u) { __builtin_amdgcn_s_sleep(2); if (++sp > (1u << 20)) break; }
        __builtin_amdgcn_fence(__ATOMIC_ACQUIRE, "agent");
        asm volatile("s_waitcnt vmcnt(0)" ::: "memory"); }
    __syncthreads();
    final_phase(p, MP);
}

#define XB_TMO      128
#define XB_XCNT(j)  (256  + 64 * (j))
#define XB_XSUB(j)  (1280 + 64 * (j))
#define XB_XGEN(j)  (2304 + 64 * (j))
#define XB_TOP      3328
#define XB_TOPGEN   3392
#define XCD_BAR_WORDS 3456
#define XB_SPIN_CAP (1u << 18)
static_assert(XCD_BAR_WORDS * 4 <= 16384, "barrier words");
__device__ __forceinline__ unsigned xb_ld(unsigned* p)              { return __hip_atomic_load(p, __ATOMIC_RELAXED, __HIP_MEMORY_SCOPE_AGENT); }
__device__ __forceinline__ unsigned xb_add(unsigned* p, unsigned v) { return __hip_atomic_fetch_add(p, v, __ATOMIC_RELAXED, __HIP_MEMORY_SCOPE_AGENT); }
__device__ __forceinline__ unsigned xb_xcc_id() { return (unsigned)__builtin_amdgcn_s_getreg((3 << 11) | 20) & 0xFu; }
#define XB_SPIN(cond, bar) do { unsigned _sp = 0; while (cond) { __builtin_amdgcn_s_sleep(1); \
    if ((++_sp & 255u) == 0u) { if (xb_ld(&(bar)[XB_TMO])) break; if (_sp > XB_SPIN_CAP) { atomicAdd(&(bar)[XB_TMO], 1u); break; } } } } while (0)
struct XcdBarrier { unsigned* bar; unsigned x; volatile LAS unsigned* st; };
__device__ __forceinline__ XcdBarrier xcd_barrier_post(unsigned* bar, volatile LAS unsigned* st) {
    XcdBarrier b; b.bar = bar; b.x = xb_xcc_id(); b.st = st;
    if (threadIdx.x == 0) (void)xb_add(&bar[XB_XCNT(b.x)], 1u);
    return b;
}
__device__ __forceinline__ void xcd_barrier_complete(unsigned* bar, unsigned x, unsigned& nloc, unsigned& nx) {
    const unsigned G = gridDim.x * gridDim.y * gridDim.z;
    unsigned sum, cnt, mine, sp = 0u;
    for (;;) {
        sum = 0u; cnt = 0u; mine = 0u;
#pragma unroll
        for (unsigned j = 0; j < 16; ++j) { const unsigned c = xb_ld(&bar[XB_XCNT(j)]); sum += c; cnt += (c > 0u) ? 1u : 0u; mine = (j == x) ? c : mine; }
        if (sum == G) break;
        __builtin_amdgcn_s_sleep(1);
        if ((++sp & 255u) == 0u) { if (xb_ld(&bar[XB_TMO])) break; if (sp > XB_SPIN_CAP) { atomicAdd(&bar[XB_TMO], 1u); break; } }
    }
    nloc = mine > 0u ? mine : 1u; nx = cnt > 0u ? cnt : 1u;
}
__device__ __forceinline__ void xcd_barrier(const XcdBarrier& b) {
    asm volatile("s_waitcnt vmcnt(0)" ::: "memory");
    __syncthreads();
    if (threadIdx.x == 0) {
        unsigned* bar = b.bar;
        __builtin_amdgcn_s_waitcnt(0);
        unsigned nloc = b.st[0], nx = b.st[1];
        if (nloc == 0u) { xcd_barrier_complete(bar, b.x, nloc, nx); b.st[0] = nloc; b.st[1] = nx; }
        const unsigned old = xb_add(&bar[XB_XSUB(b.x)], 1u);
        const unsigned gen = old / nloc;
        if (old + 1u == (gen + 1u) * nloc) {
            __builtin_amdgcn_fence(__ATOMIC_RELEASE, "agent");
            asm volatile("s_waitcnt vmcnt(0)" ::: "memory");
            const unsigned og = xb_add(&bar[XB_TOP], 1u);
            const unsigned tg = og / nx;
            if (og + 1u == (tg + 1u) * nx) xb_add(&bar[XB_TOPGEN], 1u);
            else XB_SPIN(xb_ld(&bar[XB_TOPGEN]) == tg, bar);
            __builtin_amdgcn_fence(__ATOMIC_ACQUIRE, "agent");
            asm volatile("s_waitcnt vmcnt(0)" ::: "memory");
        } else {
            XB_SPIN(xb_ld(&bar[XB_TOPGEN]) == gen, bar);
            __builtin_amdgcn_fence(__ATOMIC_ACQUIRE, "agent");
            asm volatile("s_waitcnt vmcnt(0)" ::: "memory");
        }
    }
    __syncthreads();
}

__global__ void __launch_bounds__(512, 2) mega_fwd(Params p) {
    extern __shared__ __attribute__((aligned(16))) unsigned char lds_raw[];
    LAS unsigned char* lds = (LAS unsigned char*)lds_raw;
    const int lo = p.ph_lo, hi = p.ph_hi;
#define IN(k) (lo <= (k) && (k) < hi)
#define SEAM(k) do { if (IN(k) && IN((k) + 1)) xcd_barrier(bar); } while (0)
    unsigned char* ws = p.ws;
    volatile LAS unsigned* stw = (volatile LAS unsigned*)(lds + LDS_STAGE);
    if (threadIdx.x < 4) stw[threadIdx.x] = 0u;
    __syncthreads();
    XcdBarrier bar; bar.bar = (unsigned*)(ws + OFF_BAR); bar.x = 0; bar.st = stw;
    if (hi - lo > 1) bar = xcd_barrier_post((unsigned*)(ws + OFF_BAR), stw);
    bf16_t* XB = (bf16_t*)(ws + OFF_XB); bf16_t* ZB = (bf16_t*)(ws + OFF_ZB); bf16_t* MIXB = (bf16_t*)(ws + OFF_MIXB); bf16_t* HB = (bf16_t*)(ws + OFF_HB);
    float* ST0 = (float*)(ws + OFF_ST); float* ST1 = (float*)(ws + OFF_ST + ST_BYTES); float* ST2 = (float*)(ws + OFF_ST + 2 * ST_BYTES);
    float* STV = (float*)(ws + OFF_ST + 3 * ST_BYTES); float* ST3 = (float*)(ws + OFF_ST + 4 * ST_BYTES); float* ST4 = (float*)(ws + OFF_ST + 5 * ST_BYTES);

    if (IN(0)) { prep_phase(p, lds); } SEAM(0);
    if (IN(1)) { const EpiArgs E{ZB, 2048, nullptr, ST0, nullptr, nullptr, nullptr, nullptr, nullptr}; const bf16_t* W = (const bf16_t*)(ws + OFF_W_INE);
        gemm_phase<EK_SCALE, EK_SCALE>(lds, XB, W, 64, 2048, 1024, E); } SEAM(1);
    if (IN(2)) { mixer_phase(p, lds); } SEAM(2);
    if (IN(3)) { const EpiArgs E{XB, 1024, XB, nullptr, ST1, nullptr, nullptr, nullptr, nullptr}; const bf16_t* W = (const bf16_t*)(ws + OFF_W_OUTE);
        gemm_phase<EK_RES, EK_RES>(lds, MIXB, W, 64, 1024, 1024, E); } SEAM(3);
    if (IN(4)) { const EpiArgs E{HB, DFF, nullptr, ST1, nullptr, nullptr, nullptr, nullptr, nullptr}; const bf16_t* W = (const bf16_t*)(ws + OFF_W_GU0);
        gemm_phase<EK_SWIGLU>(lds, XB, W, 65  , 2 * DFF, 1024, E);
        {
            const int G_ = (int)gridDim.x, nwg_ = 65 * 22, busy_ = nwg_ - ((nwg_ - 1) / G_) * G_, c_ = (int)blockIdx.x;
            const int nidle_ = G_ - busy_;
            if (nidle_ == 0) { prep_tiles(p, lds, NT_L0 + c_, NT_ALL, G_); prep_ws(p, c_, G_); }
            else if (c_ >= busy_) { prep_tiles(p, lds, NT_L0 + (c_ - busy_), NT_ALL, nidle_); prep_ws(p, c_ - busy_, nidle_); }
        } } SEAM(4);
    if (IN(5)) { const EpiArgs E{XB, 1024, XB, nullptr, ST2, nullptr, nullptr, nullptr, nullptr}; const bf16_t* W = (const bf16_t*)(ws + OFF_W_DN0);
        gemm_phase<EK_RES, EK_RES>(lds, HB, W, 64, 1024, DFF, E); } SEAM(5);
    if (IN(6)) { const EpiArgs E{ZB, 2048, nullptr, ST2, STV, nullptr, nullptr, nullptr, nullptr}; const bf16_t* W = (const bf16_t*)(ws + OFF_W_INO);
        gemm_phase<EK_GELU, EK_GELU>(lds, XB, W, 64, 2048, 1024, E); } SEAM(6);
    if (IN(7)) { gating_phase(p, lds); } SEAM(7);
    if (IN(8)) { const EpiArgs E{XB, 1024, XB, nullptr, ST3, nullptr, nullptr, nullptr, nullptr}; const bf16_t* W = (const bf16_t*)(ws + OFF_W_OUTO);
        gemm_phase<EK_RES, EK_RES>(lds, MIXB, W, 64, 1024, 1024, E); } SEAM(8);
    if (IN(9)) { const EpiArgs E{HB, DFF, nullptr, ST3, nullptr, nullptr, nullptr, nullptr, nullptr}; const bf16_t* W = (const bf16_t*)(ws + OFF_W_GU1);
        gemm_phase<EK_SWIGLU>(lds, XB, W, 65  , 2 * DFF, 1024, E); } SEAM(9);
    const bool fuse_final = (gridDim.x == 256);
    if (IN(10)) { unsigned* scnt = (unsigned*)(ws + OFF_BAR) + 8192;
        const EpiArgs E{XB, 1024, XB, nullptr, ST4, p.out, p.in[6], (unsigned*)(ws + OFF_BAR) + 4096, fuse_final ? scnt : nullptr}; const bf16_t* W = (const bf16_t*)(ws + OFF_W_DN1);
        if (fuse_final) gemm_phase<EK_FINAL, EK_RES>(lds, HB, W, 64, 1024, DFF, E);
        else gemm_phase<EK_RES, EK_RES>(lds, HB, W, 64, 1024, DFF, E); }
    if (!fuse_final) { SEAM(10); if (IN(11)) final_phase(p, 0); }
#undef IN
#undef SEAM
}

extern "C" void kernel_launch(void* const* d_in, const int* in_sizes, int n_in, void* d_out, int out_size, void* d_ws, size_t ws_size, hipStream_t stream) {
    static int grid = 0;
    if (grid == 0) {
        if (n_in != 20 || ws_size < WS_END) { fprintf(stderr, "kernel_launch: unexpected n_in %d or ws_size %zu (need %zu)\n", n_in, ws_size, (size_t)WS_END); grid = -1; return; }
        int dev = 0, cus = 0, per_cu = 0;
        hipGetDevice(&dev);
        hipDeviceGetAttribute(&cus, hipDeviceAttributeMultiprocessorCount, dev);
        if (hipFuncSetAttribute((const void*)mega_fwd, hipFuncAttributeMaxDynamicSharedMemorySize, LDS_BYTES) != hipSuccess) { fprintf(stderr, "kernel_launch: hipFuncSetAttribute failed\n"); grid = -1; return; }
        if (hipOccupancyMaxActiveBlocksPerMultiprocessor(&per_cu, (const void*)mega_fwd, 512, LDS_BYTES) != hipSuccess || per_cu < 1) { fprintf(stderr, "kernel_launch: occupancy query gave %d\n", per_cu); per_cu = 1; }
        (void)hipGetLastError();
        grid = cus * (per_cu > 1 ? 1 : per_cu);
        if (grid <= 0) grid = 256;
    }
    if (grid < 0) return;
    Params p{};
    for (int i = 0; i < 20; ++i) p.in[i] = (const float*)d_in[i];
    p.out = (float*)d_out; p.ws = (unsigned char*)d_ws;
#if N_LAUNCHES == 1
    if (hipMemsetAsync((unsigned char*)d_ws + OFF_BAR, 0, BAR_BYTES, stream) != hipSuccess) { fprintf(stderr, "kernel_launch: memset of the barrier words failed\n"); return; }
    p.ph_lo = 0; p.ph_hi = NPHASE;
    void* args[] = {&p};
    hipError_t e = hipLaunchCooperativeKernel((const void*)mega_fwd, dim3(grid), dim3(512), args, LDS_BYTES, stream);
    if (e != hipSuccess) fprintf(stderr, "cooperative launch failed: %s (grid %d)\n", hipGetErrorString(e), grid);
#else
    for (int k = 0; k < NPHASE; ++k) {
        p.ph_lo = k; p.ph_hi = k + 1;
        hipLaunchKernelGGL(mega_fwd, dim3(grid), dim3(512), LDS_BYTES, stream, p);
    }
#endif
}
```
